# Optimizing an MI355X kernel written in HIP

```python
import jax, jax.numpy as jnp
from jax import lax
import numpy as np

D_MODEL = 1024
BATCH = 4
SEQ = 8192
DEPTH = 4

N_GROUPS = 4
FOURIER_WIDTH = 512
FOURIER_GROUP = FOURIER_WIDTH // N_GROUPS
CONV_WIDTH = 512
CONV_K = 3
POOL_WIDTH = 512
POOL_GROUP = POOL_WIDTH // N_GROUPS
POOL_WINDOWS = (2, 4, 8, 16)
OUT_GROUP = D_MODEL // N_GROUPS
N_BRANCHES = 3
D_FF = 2816
EPS = 1e-6

OFF_F = 0
OFF_B = OFF_F + FOURIER_WIDTH
OFF_C = OFF_B + CONV_WIDTH
OFF_V = OFF_C + CONV_WIDTH
OFF_P = OFF_V + CONV_WIDTH
OFF_G = OFF_P + POOL_WIDTH
IN_WIDTH = OFF_G + N_BRANCHES * D_MODEL

kernel_name = "hybrid_fourier_conv_pool_macaron_encoder"


def rmsnorm(x, g):
    xf = x.astype(jnp.float32)
    y = xf * lax.rsqrt(jnp.mean(xf * xf, axis=-1, keepdims=True) + EPS)
    return (y * g.astype(jnp.float32)).astype(x.dtype)


def swiglu(h, w1, w3, w2):
    return (jax.nn.silu(h @ w1) * (h @ w3)) @ w2


def fourier_mix(u, w_map):
    b, s, _ = u.shape
    ug = u.reshape(b, s, N_GROUPS, FOURIER_GROUP).astype(jnp.float32)
    f = jnp.fft.fftn(ug, axes=(1, 3), norm="ortho").real.astype(u.dtype)
    y = jnp.einsum("bsgc,gcd->bsgd", f, w_map)
    return y.reshape(b, s, D_MODEL)


def short_conv(bg, cg, v, w_conv, w_out):
    z = cg * v
    zp = jnp.pad(z, ((0, 0), (1, 1), (0, 0)))
    conv = w_conv[0] * zp[:, :-2] + w_conv[1] * zp[:, 1:-1] + w_conv[2] * zp[:, 2:]
    return (bg * conv) @ w_out


def pool_mix(u, w_map, scale):
    s = u.shape[1]
    t = jnp.arange(s, dtype=jnp.float32)
    outs = []
    for i, w in enumerate(POOL_WINDOWS):
        half = w // 2
        ug = u[..., i * POOL_GROUP:(i + 1) * POOL_GROUP].astype(jnp.float32)
        cs = jnp.pad(jnp.cumsum(ug, axis=1), ((0, 0), (1, 0), (0, 0)))
        padded = jnp.pad(cs, ((0, 0), (half, half), (0, 0)), mode="edge")
        win = padded[:, w:w + s] - padded[:, :s]
        count = jnp.minimum(t + half, float(s)) - jnp.maximum(t - half, 0.0)
        pooled = win / count[None, :, None] - ug
        outs.append(pooled.astype(u.dtype) @ w_map[i])
    return jnp.concatenate(outs, axis=-1) * scale


def setup_inputs(seed: int = 0) -> dict:
    key = jax.random.key(seed)
    ks = jax.random.split(key, 20)
    f32 = jnp.float32

    def nrm(k, shape, fan_in):
        return jax.random.normal(k, shape, f32) * (fan_in ** -0.5)

    def gain(k, shape):
        return 1.0 + 0.02 * jax.random.normal(k, shape, f32)

    L, D = DEPTH, D_MODEL
    return {
        "x": jax.random.normal(ks[0], (BATCH, SEQ, D), f32),
        "g_ffn1": gain(ks[1], (L, D)),
        "w1_a": nrm(ks[2], (L, D, D_FF), D),
        "w3_a": nrm(ks[3], (L, D, D_FF), D),
        "w2_a": nrm(ks[4], (L, D_FF, D), D_FF),
        "g_mix": gain(ks[5], (L, D)),
        "w_in": nrm(ks[6], (L, D, IN_WIDTH), D),
        "w_fourier": nrm(ks[7], (L, N_GROUPS, FOURIER_GROUP, OUT_GROUP), FOURIER_GROUP),
        "w_conv": nrm(ks[8], (L, CONV_K, CONV_WIDTH), CONV_K),
        "w_conv_out": nrm(ks[9], (L, CONV_WIDTH, D), CONV_WIDTH),
        "w_pool": nrm(ks[10], (L, N_GROUPS, POOL_GROUP, OUT_GROUP), POOL_GROUP),
        "pool_scale": gain(ks[11], (L, D)),
        "w_o": nrm(ks[12], (L, D, D), D),
        "g_ffn2": gain(ks[13], (L, D)),
        "w1_b": nrm(ks[14], (L, D, D_FF), D),
        "w3_b": nrm(ks[15], (L, D, D_FF), D),
        "w2_b": nrm(ks[16], (L, D_FF, D), D_FF),
        "g_final": gain(ks[17], (D,)),
    }


def reference(x, g_ffn1, w1_a, w3_a, w2_a, g_mix, w_in, w_fourier, w_conv, w_conv_out,
              w_pool, pool_scale, w_o, g_ffn2, w1_b, w3_b, w2_b, g_final):
    b, s, d = x.shape
    for l in range(DEPTH):
        h = rmsnorm(x, g_ffn1[l])
        x = x + 0.5 * swiglu(h, w1_a[l], w3_a[l], w2_a[l])

        h = rmsnorm(x, g_mix[l])
        p = h @ w_in[l]
        gates = jax.nn.sigmoid(p[..., OFF_G:].astype(jnp.float32)).astype(x.dtype)
        gates = gates.reshape(b, s, N_BRANCHES, d)
        y_f = fourier_mix(p[..., OFF_F:OFF_B], w_fourier[l])
        y_c = short_conv(p[..., OFF_B:OFF_C], p[..., OFF_C:OFF_V], p[..., OFF_V:OFF_P],
                         w_conv[l], w_conv_out[l])
        y_p = pool_mix(p[..., OFF_P:OFF_G], w_pool[l], pool_scale[l])
        merged = gates[:, :, 0] * y_f + gates[:, :, 1] * y_c + gates[:, :, 2] * y_p
        x = x + merged @ w_o[l]

        h = rmsnorm(x, g_ffn2[l])
        x = x + 0.5 * swiglu(h, w1_b[l], w3_b[l], w2_b[l])
    return rmsnorm(x, g_final)
```

```cpp
#include <hip/hip_runtime.h>
#include <hip/hip_cooperative_groups.h>
#include <cstdio>
namespace cg = cooperative_groups;

#define LAS __attribute__((address_space(3)))
#define GAS __attribute__((address_space(1)))
typedef unsigned short bf16_t;
typedef short bf16x8 __attribute__((ext_vector_type(8)));
typedef float f32x4 __attribute__((ext_vector_type(4)));
typedef unsigned u32x4 __attribute__((ext_vector_type(4)));
typedef unsigned u32x2 __attribute__((ext_vector_type(2)));

constexpr int T_ = 32768, D_ = 1024, FF_ = 2816, S_ = 8192, INW_ = 5632, DEPTH_ = 4;
constexpr float EPS_ = 1e-6f;

constexpr size_t WS_BAR = 192 * 1024;
constexpr size_t WS_SSP = 1 << 20;
constexpr size_t WS_W = 3 << 20;
constexpr size_t W13A = WS_W;
constexpr size_t W2A = W13A + (size_t)INW_ * D_ * 2;
constexpr size_t WIN = W2A + (size_t)D_ * FF_ * 2;
constexpr size_t WF = WIN + (size_t)INW_ * D_ * 2;
constexpr size_t WP = WF + (size_t)1024 * 512 * 2;
constexpr size_t WCO = WP + (size_t)1024 * 512 * 2;
constexpr size_t WO = WCO + (size_t)1024 * 512 * 2;
constexpr size_t W13B = WO + (size_t)1024 * 1024 * 2;
constexpr size_t W2B = W13B + (size_t)INW_ * D_ * 2;
constexpr size_t WEND = W2B + (size_t)D_ * FF_ * 2;
constexpr size_t WS_XB = (WEND + 4095) & ~(size_t)4095;
constexpr size_t WS_BIG = WS_XB + (size_t)T_ * 1024 * 2;
constexpr size_t WS_P1 = WS_BIG + (size_t)T_ * 3072 * 2;
constexpr size_t WS_P2 = WS_P1 + (size_t)T_ * 2048 * 2;
constexpr size_t WS_END = WS_P2 + (size_t)T_ * 1024 * 2;

struct Params {
    const float* in[18];
    float* out; unsigned char* ws;
    int ph_lo, ph_hi, coop, pad;
};
enum { I_X = 0, I_GF1, I_W1A, I_W3A, I_W2A, I_GMIX, I_WIN, I_WFOUR, I_WCONV, I_WCONVOUT, I_WPOOL, I_PSCALE, I_WO, I_GF2, I_W1B, I_W3B, I_W2B, I_GFINAL };

constexpr int LDS_RS = 8 * 128 * 64 * 2 + 256 + 4096;
constexpr int LDS_RED = 8 * 128 * 64 * 2 + 256;
constexpr int LDS_TBL = 8 * 128 * 64 * 2 + 64;
#define inp(p, i) lds_ptr(shm, (i))
__device__ __forceinline__ const float* lds_ptr(const unsigned char* shm, int i) {
    const unsigned long long v = *(const volatile LAS unsigned long long*)((const LAS unsigned char*)shm + LDS_TBL + 8 * i);
    const unsigned lo = __builtin_amdgcn_readfirstlane((unsigned)v), hi = __builtin_amdgcn_readfirstlane((unsigned)(v >> 32));
    return (const float*)(((unsigned long long)hi << 32) | lo);
}
__device__ __forceinline__ unsigned cvt_pk_bf16(float lo, float hi) { unsigned r; asm volatile("v_cvt_pk_bf16_f32 %0, %1, %2" : "=v"(r) : "v"(lo), "v"(hi)); return r; }
__device__ __forceinline__ unsigned pack_u8x4(float a, float b, float c, float d) {
    unsigned r = 0u; r = __builtin_amdgcn_cvt_pk_u8_f32(a, 0u, r); r = __builtin_amdgcn_cvt_pk_u8_f32(b, 1u, r); r = __builtin_amdgcn_cvt_pk_u8_f32(c, 2u, r); r = __builtin_amdgcn_cvt_pk_u8_f32(d, 3u, r); return r;
}
__device__ __forceinline__ float ubf(unsigned w, int k) { return (float)((w >> (8 * k)) & 0xffu); }
__device__ __forceinline__ float bf_lo(unsigned w) { return __uint_as_float(w << 16); }
__device__ __forceinline__ float bf_hi(unsigned w) { return __uint_as_float(w & 0xffff0000u); }
__device__ __forceinline__ int fresh_lane() { int z; asm volatile("v_mov_b32 %0, 0" : "=v"(z)); return (int)__builtin_amdgcn_mbcnt_hi(~0u, __builtin_amdgcn_mbcnt_lo(~0u, (unsigned)z)); }
__device__ __forceinline__ float row_rs(const float* ssp, int row) {
    const f32x4 a = *(const f32x4*)(ssp + (size_t)row * 4);
    return 1.0f / sqrtf(((a.x + a.y) + (a.z + a.w)) * (1.0f / D_) + EPS_);
}
__device__ __forceinline__ float lds_rs(const LAS float* rsl, int rl) {
    const f32x4 a = *(const LAS f32x4*)(rsl + rl * 4);
    return __builtin_amdgcn_rsqf(((a.x + a.y) + (a.z + a.w)) * (1.0f / D_) + EPS_);
}
__device__ __forceinline__ float bperm(float v, int srclane) { return __int_as_float(__builtin_amdgcn_ds_bpermute(srclane << 2, __float_as_int(v))); }
__device__ __forceinline__ float wave_sum(float v, int lane) {
#pragma unroll
    for (int o = 1; o < 64; o <<= 1) v += bperm(v, lane ^ o);
    return v;
}

constexpr int BM = 256, BK = 64, HALF = 128, HTB = HALF * BK * 2, STAGE_BYTES = 8 * HTB, NXCD = 8, WGM = 8;
__host__ __device__ __forceinline__ int lds_byte(int r, int c) { const int st = (r >> 4) * 2 + (c >> 5), rr = r & 15, cc = c & 31, ob = rr * 64 + cc * 2; return st * 1024 + (ob ^ (((ob >> 9) & 1) << 5)); }
__host__ __device__ __forceinline__ void stage_rc(int b, int& R, int& C) { const int st = b / 1024, sb = b % 1024, swz = sb ^ (((sb >> 9) & 1) << 5); R = (st >> 1) * 16 + swz / 64; C = (st & 1) * 32 + (swz % 64) / 2; }
__host__ __device__ __forceinline__ int perm32(int rho) { const int n = rho >> 4, i = rho & 15; return 8 * (i >> 2) + 4 * n + (i & 3); }

struct Unit { int pm, pn, seg; };
struct Gemm { const bf16_t* A; const bf16_t* Bt; int lda, ldb, K, M, N, acs; };
struct StaticOrder {
    int nM, nN, nwg, G, c;
    __device__ void init(int M, int N, int G_, int c_) { nM = M / BM; nN = N / BM; nwg = nM * nN; G = G_; c = c_; }
    __device__ bool next(int i, Unit& u) const {
        const long L = (long)i * G + c; if (L >= nwg) return false;
        int wgid = (int)L; { const int q = nwg / NXCD, r = nwg % NXCD, xcd = wgid % NXCD, off = wgid / NXCD; wgid = (xcd < r ? xcd * (q + 1) : r * (q + 1) + (xcd - r) * q) + off; }
        const int nig = WGM * nN, gid = wgid / nig, fm = gid * WGM, gsz = (nM - fm) < WGM ? (nM - fm) : WGM;
        u.pm = fm + ((wgid % nig) % gsz); u.pn = (wgid % nig) / gsz; return true;
    }
};

typedef f32x4 Acc[2][2][4][2];

struct EpiSwiglu {
    static constexpr bool PERM = true, PREFETCH = true;
    bf16_t* H; const float* r; const LAS float* rsl;
    __device__ __forceinline__ void operator()(const Acc& acc, const Unit& u, int wr, int wc, int fr, int fq) const {
        const int rl0 = wr * 64 + fr, row0 = u.pm * BM + rl0, col0 = u.pn * 128 + wc * 32 + 8 * fq;
#pragma unroll
        for (int ai = 0; ai < 2; ++ai)
#pragma unroll
            for (int m = 0; m < 4; ++m) {
                const int row = row0 + ai * HALF + m * 16; const float rs = lds_rs(rsl, rl0 + ai * HALF + m * 16);
                float a[8], b[8], e[8];
#pragma unroll
                for (int j = 0; j < 8; ++j) { a[j] = acc[ai][0][m][j >> 2][j & 3] * rs; b[j] = acc[ai][1][m][j >> 2][j & 3] * rs; e[j] = a[j] * -1.4426950408889634f; }
                __builtin_amdgcn_sched_barrier(0);
#pragma unroll
                for (int j = 0; j < 8; ++j) e[j] = __builtin_amdgcn_exp2f(e[j]);
                __builtin_amdgcn_sched_barrier(0);
#pragma unroll
                for (int j = 0; j < 8; ++j) { e[j] = e[j] + 1.0f; b[j] = a[j] * b[j]; }
                __builtin_amdgcn_sched_barrier(0);
#pragma unroll
                for (int j = 0; j < 8; ++j) e[j] = __builtin_amdgcn_rcpf(e[j]);
                __builtin_amdgcn_sched_barrier(0);
#pragma unroll
                for (int j = 0; j < 8; ++j) e[j] = e[j] * b[j];
                u32x4 w; w.x = cvt_pk_bf16(e[0], e[1]); w.y = cvt_pk_bf16(e[2], e[3]); w.z = cvt_pk_bf16(e[4], e[5]); w.w = cvt_pk_bf16(e[6], e[7]);
                *(GAS u32x4*)(H + (size_t)row * FF_ + col0) = w;
            }
    }
};
struct EpiResid {
    static constexpr bool PERM = true, PREFETCH = false;
    const bf16_t* XR; bf16_t* XO; float* SSP; float scale; LAS float* red;
    __device__ __forceinline__ void operator()(const Acc& acc, const Unit& u, int wr, int wc, int fr, int fq) const {
        const int row0 = u.pm * BM + wr * 64 + fr, col0 = u.pn * BM + wc * 32 + 8 * fq;
        const GAS bf16_t* xbase = (const GAS bf16_t*)XR + (size_t)row0 * D_ + col0; GAS bf16_t* obase = (GAS bf16_t*)XO + (size_t)row0 * D_ + col0;
        u32x4 xv[4][2];
#define RS_LOAD(s) do { const GAS bf16_t* rp_ = xbase + (size_t)((((s) >> 2) * HALF) + ((s) & 3) * 16) * D_; \
        xv[(s) & 3][0] = *(const GAS u32x4*)(rp_); xv[(s) & 3][1] = *(const GAS u32x4*)(rp_ + HALF); } while (0)
        RS_LOAD(0); RS_LOAD(1); RS_LOAD(2); RS_LOAD(3);
        const int l0 = fq * 16 + fr;
#pragma unroll
        for (int st = 0; st < 8; ++st) {
            const int ai = st >> 2, m = st & 3; const size_t ro = (size_t)(ai * HALF + m * 16) * D_;
            float sq = 0.f;
#pragma unroll
            for (int bj = 0; bj < 2; ++bj) { const u32x4 xo = xv[st & 3][bj]; const f32x4 a0 = acc[ai][bj][m][0], a1 = acc[ai][bj][m][1];
                const float v0 = bf_lo(xo.x) + a0.x * scale, v1 = bf_hi(xo.x) + a0.y * scale, v2 = bf_lo(xo.y) + a0.z * scale, v3 = bf_hi(xo.y) + a0.w * scale;
                const float v4 = bf_lo(xo.z) + a1.x * scale, v5 = bf_hi(xo.z) + a1.y * scale, v6 = bf_lo(xo.w) + a1.z * scale, v7 = bf_hi(xo.w) + a1.w * scale;
                sq += ((v0 * v0 + v1 * v1) + (v2 * v2 + v3 * v3)) + ((v4 * v4 + v5 * v5) + (v6 * v6 + v7 * v7));
                *(GAS u32x4*)(obase + ro + bj * HALF) = (u32x4){cvt_pk_bf16(v0, v1), cvt_pk_bf16(v2, v3), cvt_pk_bf16(v4, v5), cvt_pk_bf16(v6, v7)}; }
            if (st + 4 < 8) { RS_LOAD(st + 4); }
            sq += bperm(sq, l0 ^ 16); sq += bperm(sq, l0 ^ 32);
            if (fq == 0) red[(ai * HALF + wr * 64 + m * 16 + fr) * 4 + wc] = sq;
        }
#undef RS_LOAD
        asm volatile("s_waitcnt lgkmcnt(0)" ::: "memory");
        __builtin_amdgcn_s_barrier(); __builtin_amdgcn_s_barrier();
        asm volatile("" ::: "memory");
        if (l0 < 32) { const int rl = (wr * 4 + wc) * 32 + l0; const f32x4 t = *(const LAS f32x4*)(red + rl * 4);
            *(GAS float*)(SSP + (size_t)(u.pm * BM + rl) * 4 + u.pn) = (t.x + t.y) + (t.z + t.w); }
    }
};
struct EpiIn {
    static constexpr bool PERM = true, PREFETCH = true;
    bf16_t *Uq, *Bv, *Z, *Pu, *Gt; const float* r; const LAS float* rsl;
    __device__ __forceinline__ void operator()(const Acc& acc, const Unit& u, int wr, int wc, int fr, int fq) const {
        const int rl0 = wr * 64 + fr, row0 = u.pm * BM + rl0, cw = wc * 32 + 8 * fq; const int pn = u.pn;
#pragma unroll
        for (int ai = 0; ai < 2; ++ai)
#pragma unroll
            for (int m = 0; m < 4; ++m) {
                const int row = row0 + ai * HALF + m * 16; const float rs = lds_rs(rsl, rl0 + ai * HALF + m * 16);
                if (pn >= 4 && pn < 8) {
                    float h[8];
#pragma unroll
                    for (int n = 0; n < 2; ++n)
#pragma unroll
                        for (int j = 0; j < 4; ++j) h[4 * n + j] = (acc[ai][0][m][n][j] * rs) * (acc[ai][1][m][n][j] * rs);
                    u32x4 w; w.x = cvt_pk_bf16(h[0], h[1]); w.y = cvt_pk_bf16(h[2], h[3]); w.z = cvt_pk_bf16(h[4], h[5]); w.w = cvt_pk_bf16(h[6], h[7]);
                    *(GAS u32x4*)(Z + (size_t)row * 512 + (pn - 4) * 128 + cw) = w;
                } else {
                    u32x2 g0 = (u32x2){0u, 0u};
#pragma unroll
                    for (int bj = 0; bj < 2; ++bj) {
                        float h[8];
#pragma unroll
                        for (int n = 0; n < 2; ++n)
#pragma unroll
                            for (int j = 0; j < 4; ++j) h[4 * n + j] = acc[ai][bj][m][n][j] * rs;
                        if (pn >= 10) {
#pragma unroll
                            for (int j = 0; j < 8; ++j) h[j] = h[j] * -1.4426950408889634f;
                            __builtin_amdgcn_sched_barrier(0);
#pragma unroll
                            for (int j = 0; j < 8; ++j) h[j] = __builtin_amdgcn_exp2f(h[j]);
                            __builtin_amdgcn_sched_barrier(0);
#pragma unroll
                            for (int j = 0; j < 8; ++j) h[j] = h[j] + 1.0f;
                            __builtin_amdgcn_sched_barrier(0);
#pragma unroll
                            for (int j = 0; j < 8; ++j) h[j] = __builtin_amdgcn_rcpf(h[j]);
                            __builtin_amdgcn_sched_barrier(0);
                        }
                        u32x4 w; w.x = cvt_pk_bf16(h[0], h[1]); w.y = cvt_pk_bf16(h[2], h[3]); w.z = cvt_pk_bf16(h[4], h[5]); w.w = cvt_pk_bf16(h[6], h[7]);
                        const int c = bj * HALF + cw;
                        if (pn < 2) {
                            const int ch = pn * 256 + c, b = row >> 13, s = row & (S_ - 1), q = ch >> 2;
                            bf16_t* d0 = Uq + (((size_t)(b * 128 + q)) * S_ + s) * 4;
                            *(GAS u32x2*)d0 = (u32x2){w.x, w.y}; *(GAS u32x2*)(d0 + (size_t)S_ * 4) = (u32x2){w.z, w.w};
                        } else if (pn < 4) { *(GAS u32x4*)(Bv + (size_t)row * 512 + (pn - 2) * 256 + c) = w;
                        } else if (pn < 10) { *(GAS u32x4*)(Pu + (size_t)row * 512 + (pn - 8) * 256 + c) = w;
                        } else {
#pragma unroll
                            for (int j = 0; j < 8; ++j) h[j] = fmaxf(h[j] * 255.0f, 1.0f);
                            const u32x2 gq = (u32x2){pack_u8x4(h[0], h[1], h[2], h[3]), pack_u8x4(h[4], h[5], h[6], h[7])};
                            if (bj == 0) g0 = gq; else *(GAS u32x4*)((GAS unsigned char*)Gt + (size_t)row * 3072 + (pn - 10) * 256 + (wc * 4 + fq) * 16) = (u32x4){g0.x, g0.y, gq.x, gq.y}; }
                    }
                }
            }
    }
};
template <class Epi>
__device__ __forceinline__ void gemm_phase(LAS unsigned char* lds, const Gemm g, const StaticOrder& S, const Epi& E, int wid) {
    const int lane = fresh_lane(), tid = wid * 64 + lane, wr = wid >> 2, wc = wid & 3, fr = lane & 15, fq = lane >> 4;
    const int nt = g.K / BK;
    unsigned voffA[2], voffB[2];
#pragma unroll
    for (int i = 0; i < 2; ++i) { int R, C; stage_rc(tid * 16 + i * 8192, R, C); const int Rb = Epi::PERM ? ((R & ~31) + perm32(R & 31)) : R;
        voffA[i] = (unsigned)(R * g.lda + C) * 2u; voffB[i] = (unsigned)(Rb * g.ldb + C) * 2u; }
    const size_t kstep = (size_t)(BK * 2);
    const size_t hstepA = (size_t)HALF * g.lda * 2, hstepB = (size_t)HALF * g.ldb * 2;
    const size_t tstepA = 2 * hstepA, tstepB = 2 * hstepB;
    const unsigned ldsw = (unsigned)wid * 1024u;
    const int aoff = lds_byte(wr * 64 + fr, fq * 8), boff = lds_byte(wc * 32 + fr, fq * 8);
#define G_SA(b, h) (((b) * 2 + (h)) * HTB)
#define G_SB(b, h) ((4 + (b) * 2 + (h)) * HTB)
#define G_STAGE(bufoff, gbase, voff) do { _Pragma("unroll") for (int _i = 0; _i < 2; ++_i) \
        __builtin_amdgcn_global_load_lds((const unsigned*)((const char*)(gbase) + (voff)[_i]), (LAS unsigned*)(lds + (bufoff) + ldsw + _i * 8192), 16, 0, 0); } while (0)
#define G_LDA(dst, b, h) do { _Pragma("unroll") for (int m = 0; m < 4; ++m) _Pragma("unroll") for (int k = 0; k < 2; ++k) dst[m][k] = *(const LAS bf16x8*)(lds + G_SA(b, h) + aoff + m * 2048 + k * 1024); } while (0)
#define G_LDB(dst, b, h) do { _Pragma("unroll") for (int n = 0; n < 2; ++n) _Pragma("unroll") for (int k = 0; k < 2; ++k) dst[n][k] = *(const LAS bf16x8*)(lds + G_SB(b, h) + boff + n * 2048 + k * 1024); } while (0)
#define G_MMA(ai, bj, At, Bt) do { __builtin_amdgcn_s_setprio(1); _Pragma("unroll") for (int m = 0; m < 4; ++m) _Pragma("unroll") for (int n = 0; n < 2; ++n) _Pragma("unroll") for (int k = 0; k < 2; ++k) \
        acc[ai][bj][m][n] = __builtin_amdgcn_mfma_f32_16x16x32_bf16(Bt[n][k], At[m][k], acc[ai][bj][m][n], 0, 0, 0); __builtin_amdgcn_s_setprio(0); } while (0)
#define G_WAIT_V(n) asm volatile("s_waitcnt vmcnt(" #n ")" ::: "memory")
#define G_WAIT_L(n) asm volatile("s_waitcnt lgkmcnt(" #n ")" ::: "memory")
#define G_BAR __builtin_amdgcn_s_barrier()
#define G_SCHED __builtin_amdgcn_sched_barrier(0)
    Unit cur, nxt; int ui = 0;
    if (!S.next(0, cur)) return;
    Acc acc;
#pragma unroll
    for (int a = 0; a < 2; ++a)
#pragma unroll
        for (int b = 0; b < 2; ++b)
#pragma unroll
            for (int m = 0; m < 4; ++m)
#pragma unroll
                for (int n = 0; n < 2; ++n) acc[a][b][m][n] = (f32x4){0.f, 0.f, 0.f, 0.f};
    bf16x8 At[4][2], B0[2][2], B1[2][2];
    const char* cA = (const char*)g.A + (size_t)cur.pm * tstepA + (size_t)cur.pn * g.acs; const char* cB = (const char*)g.Bt + (size_t)cur.pn * tstepB;
    G_STAGE(G_SB(0, 0), cB, voffB); G_STAGE(G_SA(0, 0), cA, voffA); G_STAGE(G_SB(0, 1), cB + hstepB, voffB); G_STAGE(G_SA(0, 1), cA + hstepA, voffA);
    if (wr == 1) G_BAR;
    G_WAIT_V(4); G_BAR;
    G_STAGE(G_SB(1, 0), cB + kstep, voffB); G_STAGE(G_SA(1, 0), cA + kstep, voffA); G_STAGE(G_SB(1, 1), cB + hstepB + kstep, voffB);
    G_WAIT_V(6); G_BAR;
    for (;;) {
        const bool has_next = S.next(ui + 1, nxt);
        const char* nA = has_next ? (const char*)g.A + (size_t)nxt.pm * tstepA + (size_t)nxt.pn * g.acs : cA; const char* nB = has_next ? (const char*)g.Bt + (size_t)nxt.pn * tstepB : cB;
        for (int t = 0; t < nt; t += 2) {
            const bool last = (t == nt - 2);
            const char* a1 = cA + (size_t)(t + 1) * kstep;
            const char* a2 = last ? nA : cA + (size_t)(t + 2) * kstep; const char* b2 = last ? nB : cB + (size_t)(t + 2) * kstep;
            const char* a3 = a2 + kstep; const char* b3 = b2 + kstep;
            if constexpr (Epi::PREFETCH) { if (last) {
                __builtin_amdgcn_global_load_lds((const unsigned*)((const char*)E.r + ((size_t)cur.pm * BM + (wid & 3) * 64 + lane) * 16), (LAS unsigned*)(lds + LDS_RS + (wid & 3) * 1024), 16, 0, 0); } }
            G_LDB(B0, 0, 0); G_SCHED; G_LDA(At, 0, 0); G_STAGE(G_SA(1, 1), a1 + hstepA, voffA);
            G_WAIT_L(8); G_BAR; G_WAIT_L(0); G_MMA(0, 0, At, B0); G_BAR; G_SCHED;
            G_LDB(B1, 0, 1); G_STAGE(G_SB(0, 0), b2, voffB);
            G_BAR; G_WAIT_L(0); G_MMA(0, 1, At, B1); G_BAR;
            G_LDA(At, 0, 1); G_STAGE(G_SA(0, 0), a2, voffA);
            G_BAR; G_WAIT_L(0); G_MMA(1, 0, At, B0); G_BAR; G_SCHED;
            G_STAGE(G_SB(0, 1), b2 + hstepB, voffB);
            G_WAIT_V(6); G_BAR; G_MMA(1, 1, At, B1); G_BAR;
            G_LDB(B0, 1, 0); G_SCHED; G_LDA(At, 1, 0); G_STAGE(G_SA(0, 1), a2 + hstepA, voffA);
            G_WAIT_L(8); G_BAR; G_WAIT_L(0); G_MMA(0, 0, At, B0); G_BAR; G_SCHED;
            G_LDB(B1, 1, 1); G_STAGE(G_SB(1, 0), b3, voffB);
            G_BAR; G_WAIT_L(0); G_MMA(0, 1, At, B1); G_BAR;
            G_LDA(At, 1, 1); G_STAGE(G_SA(1, 0), a3, voffA);
            G_BAR; G_WAIT_L(0); G_MMA(1, 0, At, B0); G_BAR; G_SCHED;
            G_STAGE(G_SB(1, 1), b3 + hstepB, voffB);
            G_WAIT_V(6); G_BAR; G_MMA(1, 1, At, B1); G_BAR;
        }
        { const int l2 = fresh_lane(); E(acc, cur, wr, wc, l2 & 15, l2 >> 4); }
        if (!has_next) break;
#pragma unroll
        for (int a = 0; a < 2; ++a)
#pragma unroll
            for (int b = 0; b < 2; ++b)
#pragma unroll
                for (int m = 0; m < 4; ++m)
#pragma unroll
                    for (int n = 0; n < 2; ++n) acc[a][b][m][n] = (f32x4){0.f, 0.f, 0.f, 0.f};
        cur = nxt; cA = nA; cB = nB; ++ui;
    }
    G_WAIT_V(0);
    if (wr == 0) G_BAR;
    G_BAR;
}

struct MergeOps {
    const bf16_t *PQ, *PC, *WFp;
    __device__ __forceinline__ bool next(const StaticOrder& S, int i, Unit& u) const { const int ti = i / 3; if (!S.next(ti, u)) return false; u.seg = i - ti * 3; return true; }
    __device__ __forceinline__ int nt(const Unit& u) const { return u.seg == 0 ? 4 : (u.seg == 1 ? 2 : 8); }
    __device__ __forceinline__ const char* opA(const Unit& u) const {
        if (u.seg == 0) return (const char*)(PQ + ((size_t)(((u.pm >> 5) * 128 + u.pn * 32)) * S_ + (size_t)(u.pm & 31) * BM) * 8);
        return (const char*)(PC + (size_t)u.pm * BM * 1024 + (u.seg == 1 ? u.pn * 128 : 512)); }
    __device__ __forceinline__ void aparams(const Unit& u, int tid, unsigned& v0, unsigned& v1, unsigned& hstep, unsigned& kstep) const {
        int R0, C0, R1, C1; stage_rc(tid * 16, R0, C0); stage_rc(tid * 16 + 8192, R1, C1);
        if (u.seg == 0) { v0 = (unsigned)(C0 >> 3) * (unsigned)(S_ * 16) + (unsigned)R0 * 16u; v1 = (unsigned)(C1 >> 3) * (unsigned)(S_ * 16) + (unsigned)R1 * 16u; hstep = HALF * 16; kstep = 8u * S_ * 16u; }
        else { v0 = (unsigned)(R0 * 1024 + C0) * 2u; v1 = (unsigned)(R1 * 1024 + C1) * 2u; hstep = HALF * 1024 * 2; kstep = BK * 2; } }
    __device__ __forceinline__ const char* opB(const Unit& u) const {
        return (const char*)(WFp + (size_t)u.seg * 1024 * 512 + (size_t)u.pn * BM * 512); }
};
struct EpiMergeSeg {
    static constexpr bool PERM = true, PREFETCH = false;
    bf16_t* Mg; const bf16_t* Gt;
    __device__ __forceinline__ void run(Acc& acc, const Unit& u, int wr, int wc, int fr, int fq) const {
        const int seg = u.seg; const bool fin = seg == 2;
        const int noff = seg == 0 ? 0 : (seg == 1 ? 2048 : 1024), doff = seg == 0 ? 2048 : 1024;
        const int row0 = u.pm * BM + wr * 64 + fr, col0 = u.pn * BM + wc * 32 + 8 * fq, gcol = u.pn * BM + (wc * 4 + fq) * 16;
        const GAS unsigned char* nb = (const GAS unsigned char*)Gt + (size_t)row0 * 3072 + gcol + noff;
        const GAS unsigned char* db = (const GAS unsigned char*)Gt + (size_t)row0 * 3072 + gcol + doff;
        GAS bf16_t* mb = (GAS bf16_t*)Mg + (size_t)row0 * D_ + col0;
        u32x4 nv[8], dv[8];
#define MS_LOAD(s) do { nv[(s)] = *(const GAS u32x4*)(nb); if (!fin) dv[(s)] = *(const GAS u32x4*)(db); \
        nb += (((s) & 3) == 3 ? (HALF - 48) : 16) * 3072; db += (((s) & 3) == 3 ? (HALF - 48) : 16) * 3072; } while (0)
        MS_LOAD(0); MS_LOAD(1); MS_LOAD(2); MS_LOAD(3); MS_LOAD(4); MS_LOAD(5); MS_LOAD(6); MS_LOAD(7);
#pragma unroll
        for (int st = 0; st < 8; ++st) {
            const int ai = st >> 2, m = st & 3;
#pragma unroll
            for (int bj = 0; bj < 2; ++bj) {
                const u32x2 n_ = bj ? (u32x2){nv[st].z, nv[st].w} : (u32x2){nv[st].x, nv[st].y}, d_ = bj ? (u32x2){dv[st].z, dv[st].w} : (u32x2){dv[st].x, dv[st].y};
                float rn[8] = {ubf(n_.x, 0), ubf(n_.x, 1), ubf(n_.x, 2), ubf(n_.x, 3),
                               ubf(n_.y, 0), ubf(n_.y, 1), ubf(n_.y, 2), ubf(n_.y, 3)};
                float rd[8];
                if (fin) {
#pragma unroll
                    for (int j = 0; j < 8; ++j) rd[j] = 1.0f / 255.0f;
                } else {
                    rd[0] = ubf(d_.x, 0); rd[1] = ubf(d_.x, 1); rd[2] = ubf(d_.x, 2); rd[3] = ubf(d_.x, 3);
                    rd[4] = ubf(d_.y, 0); rd[5] = ubf(d_.y, 1); rd[6] = ubf(d_.y, 2); rd[7] = ubf(d_.y, 3);
#pragma unroll
                    for (int j = 0; j < 8; ++j) rd[j] = __builtin_amdgcn_rcpf(fmaxf(rd[j], 1.0f));
                }
#pragma unroll
                for (int j = 0; j < 8; ++j) acc[ai][bj][m][j >> 2][j & 3] *= rn[j] * rd[j];
                if (fin) { const f32x4 a0 = acc[ai][bj][m][0], a1 = acc[ai][bj][m][1];
                    u32x4 w; w.x = cvt_pk_bf16(a0.x, a0.y); w.y = cvt_pk_bf16(a0.z, a0.w); w.z = cvt_pk_bf16(a1.x, a1.y); w.w = cvt_pk_bf16(a1.z, a1.w);
                    *(GAS u32x4*)(mb + bj * HALF) = w; }
            }
            mb += ((st & 3) == 3 ? (HALF - 48) : 16) * D_;
        }
#undef MS_LOAD
    }
};
template <class Epi>
__device__ __forceinline__ void gemm_merge_phase(LAS unsigned char* lds, const MergeOps g, const StaticOrder& S, const Epi& E, int wid) {
    const int lane = fresh_lane(), tid = wid * 64 + lane, wr = wid >> 2, wc = wid & 3, fr = lane & 15, fq = lane >> 4;
    unsigned voffB[2];
#pragma unroll
    for (int i = 0; i < 2; ++i) { int R, C; stage_rc(tid * 16 + i * 8192, R, C); const int Rb = Epi::PERM ? ((R & ~31) + perm32(R & 31)) : R;
        voffB[i] = (unsigned)(Rb * 512 + C) * 2u; }
    const size_t kstep = (size_t)(BK * 2);
    const size_t hstepB = (size_t)HALF * 512 * 2;
    const unsigned ldsw = (unsigned)wid * 1024u;
    const int aoff = lds_byte(wr * 64 + fr, fq * 8), boff = lds_byte(wc * 32 + fr, fq * 8);
#define G_SA(b, h) (((b) * 2 + (h)) * HTB)
#define G_SB(b, h) ((4 + (b) * 2 + (h)) * HTB)
#define G_STAGE(bufoff, gbase, voff) do { _Pragma("unroll") for (int _i = 0; _i < 2; ++_i) \
        __builtin_amdgcn_global_load_lds((const unsigned*)((const char*)(gbase) + (voff)[_i]), (LAS unsigned*)(lds + (bufoff) + ldsw + _i * 8192), 16, 0, 0); } while (0)
#define G_STAGE_A(bufoff, gbase, v0_, v1_) do { \
        __builtin_amdgcn_global_load_lds((const unsigned*)((const char*)(gbase) + (v0_)), (LAS unsigned*)(lds + (bufoff) + ldsw), 16, 0, 0); \
        __builtin_amdgcn_global_load_lds((const unsigned*)((const char*)(gbase) + (v1_)), (LAS unsigned*)(lds + (bufoff) + ldsw + 8192), 16, 0, 0); } while (0)
#define G_LDA(dst, b, h) do { _Pragma("unroll") for (int m = 0; m < 4; ++m) _Pragma("unroll") for (int k = 0; k < 2; ++k) dst[m][k] = *(const LAS bf16x8*)(lds + G_SA(b, h) + aoff + m * 2048 + k * 1024); } while (0)
#define G_LDB(dst, b, h) do { _Pragma("unroll") for (int n = 0; n < 2; ++n) _Pragma("unroll") for (int k = 0; k < 2; ++k) dst[n][k] = *(const LAS bf16x8*)(lds + G_SB(b, h) + boff + n * 2048 + k * 1024); } while (0)
#define G_MMA(ai, bj, At, Bt) do { __builtin_amdgcn_s_setprio(1); _Pragma("unroll") for (int m = 0; m < 4; ++m) _Pragma("unroll") for (int n = 0; n < 2; ++n) _Pragma("unroll") for (int k = 0; k < 2; ++k) \
        acc[ai][bj][m][n] = __builtin_amdgcn_mfma_f32_16x16x32_bf16(Bt[n][k], At[m][k], acc[ai][bj][m][n], 0, 0, 0); __builtin_amdgcn_s_setprio(0); } while (0)
#define G_WAIT_V(n) asm volatile("s_waitcnt vmcnt(" #n ")" ::: "memory")
#define G_WAIT_L(n) asm volatile("s_waitcnt lgkmcnt(" #n ")" ::: "memory")
#define G_BAR __builtin_amdgcn_s_barrier()
#define G_SCHED __builtin_amdgcn_sched_barrier(0)
    Unit cur, nxt; int ui = 0;
    if (!g.next(S, 0, cur)) return;
    int nt = g.nt(cur);
    unsigned vc0, vc1, hc, kc, vn0, vn1, hn, kn;
    g.aparams(cur, tid, vc0, vc1, hc, kc);
    Acc acc;
#pragma unroll
    for (int a = 0; a < 2; ++a)
#pragma unroll
        for (int b = 0; b < 2; ++b)
#pragma unroll
            for (int m = 0; m < 4; ++m)
#pragma unroll
                for (int n = 0; n < 2; ++n) acc[a][b][m][n] = (f32x4){0.f, 0.f, 0.f, 0.f};
    bf16x8 At[4][2], B0[2][2], B1[2][2];
    const char* cA = g.opA(cur); const char* cB = g.opB(cur);
    G_STAGE(G_SB(0, 0), cB, voffB); G_STAGE_A(G_SA(0, 0), cA, vc0, vc1); G_STAGE(G_SB(0, 1), cB + hstepB, voffB); G_STAGE_A(G_SA(0, 1), cA + hc, vc0, vc1);
    if (wr == 1) G_BAR;
    G_WAIT_V(4); G_BAR;
    G_STAGE(G_SB(1, 0), cB + kstep, voffB); G_STAGE_A(G_SA(1, 0), cA + kc, vc0, vc1); G_STAGE(G_SB(1, 1), cB + hstepB + kstep, voffB);
    G_WAIT_V(6); G_BAR;
    for (;;) {
        const bool has_next = g.next(S, ui + 1, nxt);
        const char* nA = has_next ? g.opA(nxt) : cA; const char* nB = has_next ? g.opB(nxt) : cB;
        if (has_next) g.aparams(nxt, tid, vn0, vn1, hn, kn); else { vn0 = vc0; vn1 = vc1; hn = hc; kn = kc; }
        for (int t = 0; t < nt; t += 2) {
            const bool last = (t == nt - 2);
            const char* a1 = cA + (size_t)(t + 1) * kc;
            const char* a2 = last ? nA : cA + (size_t)(t + 2) * kc; const char* b2 = last ? nB : cB + (size_t)(t + 2) * kstep;
            const unsigned w0 = last ? vn0 : vc0, w1 = last ? vn1 : vc1, h2 = last ? hn : hc, k2 = last ? kn : kc;
            const char* a3 = a2 + k2; const char* b3 = b2 + kstep;
            if constexpr (Epi::PREFETCH) { if (last) {
                __builtin_amdgcn_global_load_lds((const unsigned*)((const char*)E.r + ((size_t)cur.pm * BM + (wid & 3) * 64 + lane) * 16), (LAS unsigned*)(lds + LDS_RS + (wid & 3) * 1024), 16, 0, 0); } }
            G_LDB(B0, 0, 0); G_SCHED; G_LDA(At, 0, 0); G_STAGE_A(G_SA(1, 1), a1 + hc, vc0, vc1);
            G_WAIT_L(8); G_BAR; G_WAIT_L(0); G_MMA(0, 0, At, B0); G_BAR; G_SCHED;
            G_LDB(B1, 0, 1); G_STAGE(G_SB(0, 0), b2, voffB);
            G_BAR; G_WAIT_L(0); G_MMA(0, 1, At, B1); G_BAR;
            G_LDA(At, 0, 1); G_STAGE_A(G_SA(0, 0), a2, w0, w1);
            G_BAR; G_WAIT_L(0); G_MMA(1, 0, At, B0); G_BAR; G_SCHED;
            G_STAGE(G_SB(0, 1), b2 + hstepB, voffB);
            G_WAIT_V(6); G_BAR; G_MMA(1, 1, At, B1); G_BAR;
            G_LDB(B0, 1, 0); G_SCHED; G_LDA(At, 1, 0); G_STAGE_A(G_SA(0, 1), a2 + h2, w0, w1);
            G_WAIT_L(8); G_BAR; G_WAIT_L(0); G_MMA(0, 0, At, B0); G_BAR; G_SCHED;
            G_LDB(B1, 1, 1); G_STAGE(G_SB(1, 0), b3, voffB);
            G_BAR; G_WAIT_L(0); G_MMA(0, 1, At, B1); G_BAR;
            G_LDA(At, 1, 1); G_STAGE_A(G_SA(1, 0), a3, w0, w1);
            G_BAR; G_WAIT_L(0); G_MMA(1, 0, At, B0); G_BAR; G_SCHED;
            G_STAGE(G_SB(1, 1), b3 + hstepB, voffB);
            G_WAIT_V(6); G_BAR; G_MMA(1, 1, At, B1); G_BAR;
        }
        { const int l2 = fresh_lane(); E.run(acc, cur, wr, wc, l2 & 15, l2 >> 4); }
        if (!has_next) break;
        if (cur.seg == 2) {
#pragma unroll
            for (int a = 0; a < 2; ++a)
#pragma unroll
                for (int b = 0; b < 2; ++b)
#pragma unroll
                    for (int m = 0; m < 4; ++m)
#pragma unroll
                        for (int n = 0; n < 2; ++n) acc[a][b][m][n] = (f32x4){0.f, 0.f, 0.f, 0.f};
        }
        cur = nxt; cA = nA; cB = nB; ++ui; nt = g.nt(cur); vc0 = vn0; vc1 = vn1; hc = hn; kc = kn;
    }
    G_WAIT_V(0);
    if (wr == 0) G_BAR;
    G_BAR;
}


#define FFT_FN __device__ __forceinline__
struct c2 { float x, y; };
FFT_FN c2 c_add(c2 a, c2 b) { return c2{a.x + b.x, a.y + b.y}; }
FFT_FN c2 c_sub(c2 a, c2 b) { return c2{a.x - b.x, a.y - b.y}; }
FFT_FN c2 c_mul(c2 a, c2 b) { return c2{a.x * b.x - a.y * b.y, a.x * b.y + a.y * b.x}; }
template <class PX, class PT> FFT_FN void fft_r4_stage(PX X, int tid, int lq, PT tw) {
    const int q = 1 << lq, tws = 13 - (lq + 2);
#pragma unroll 1
    for (int ob = 0; ob < 2; ++ob)
#pragma unroll
    for (int ii = 0; ii < 4; ++ii) { const int it = ob * 4 + ii;
        const int idx = tid + 512 * it, seq = idx >> 11, i = idx & 2047, blk = i >> lq, j = i & (q - 1), p = seq * 8192 + (blk << (lq + 2)) + j;
        const c2 a0 = X[p], a1 = X[p + q], a2 = X[p + 2 * q], a3 = X[p + 3 * q];
        const c2 t0 = c_add(a0, a2), t1 = c_sub(a0, a2), t2 = c_add(a1, a3), d = c_sub(a1, a3), t3 = c2{d.y, -d.x};
        const c2 y0 = c_add(t0, t2), y1 = c_add(t1, t3), y2 = c_sub(t0, t2), y3 = c_sub(t1, t3);
        const int tj = j << tws;
        X[p] = y0; X[p + q] = c_mul(y1, tw[tj]); X[p + 2 * q] = c_mul(y2, tw[2 * tj]); X[p + 3 * q] = c_mul(y3, tw[3 * tj]);
    }
}
template <class PX> FFT_FN void fft_r2_last(PX X, int tid) {
    for (int it = 0; it < 16; ++it) { const int p = 2 * (tid + 512 * it); const c2 a = X[p], b = X[p + 1]; X[p] = c_add(a, b); X[p + 1] = c_sub(a, b); }
}
FFT_FN int fft_pos(int k) {
    int pos = 0;
    for (int s = 0; s < 6; ++s) { pos += (k & 3) << (11 - 2 * s); k >>= 2; }
    return pos + (k & 1);
}

struct TwHw {
    __device__ __forceinline__ c2 operator[](int k) const { const float x = (float)k * (1.0f / 8192.0f); return c2{__builtin_amdgcn_cosf(x), -__builtin_amdgcn_sinf(x)}; }
};
__device__ __forceinline__ void pool_issue(const GAS bf16_t* Pu, int tok0, int c8, int hf, u32x4 (&w)[24]) {
    const int s0 = tok0 & (S_ - 1);
    const GAS bf16_t* base = Pu + (size_t)(tok0 - s0) * 512 + c8 * 8;
#pragma unroll
    for (int i = 0; i < 24; ++i) { const int sidx = s0 - 8 + i; w[i] = (u32x4){0u, 0u, 0u, 0u}; if (i >= 8 - hf && i < 16 + hf && sidx >= 0 && sidx < S_) w[i] = *(const GAS u32x4*)(base + (size_t)sidx * 512); }
}
template <int HF> __device__ __forceinline__ void pool_consume(GAS bf16_t* Pl, int tok0, int c8, const u32x4 (&w)[24]) {
    const int s0 = tok0 & (S_ - 1);
    float a[8];
#pragma unroll
    for (int j = 0; j < 8; ++j) a[j] = 0.f;
#pragma unroll
    for (int i = 8 - HF; i < 8 + HF; ++i) { a[0] += bf_lo(w[i].x); a[1] += bf_hi(w[i].x); a[2] += bf_lo(w[i].y); a[3] += bf_hi(w[i].y); a[4] += bf_lo(w[i].z); a[5] += bf_hi(w[i].z); a[6] += bf_lo(w[i].w); a[7] += bf_hi(w[i].w); }
    GAS bf16_t* dst = Pl + (size_t)tok0 * 1024 + c8 * 8;
#pragma unroll
    for (int j = 0; j < 8; ++j) {
        const int t = s0 + j; const int lo = t - HF < 0 ? 0 : t - HF, hi = t + HF > S_ ? S_ : t + HF; const float ic = 1.0f / (float)(hi - lo);
        const u32x4 u = w[8 + j];
        u32x4 o; o.x = cvt_pk_bf16(a[0] * ic - bf_lo(u.x), a[1] * ic - bf_hi(u.x)); o.y = cvt_pk_bf16(a[2] * ic - bf_lo(u.y), a[3] * ic - bf_hi(u.y));
        o.z = cvt_pk_bf16(a[4] * ic - bf_lo(u.z), a[5] * ic - bf_hi(u.z)); o.w = cvt_pk_bf16(a[6] * ic - bf_lo(u.w), a[7] * ic - bf_hi(u.w));
        *(GAS u32x4*)(dst + (size_t)j * 1024) = o;
        if (j < 7) { const u32x4 p = w[8 + HF + j], q = w[8 - HF + j];
            a[0] += bf_lo(p.x) - bf_lo(q.x); a[1] += bf_hi(p.x) - bf_hi(q.x); a[2] += bf_lo(p.y) - bf_lo(q.y); a[3] += bf_hi(p.y) - bf_hi(q.y);
            a[4] += bf_lo(p.z) - bf_lo(q.z); a[5] += bf_hi(p.z) - bf_hi(q.z); a[6] += bf_lo(p.w) - bf_lo(q.w); a[7] += bf_hi(p.w) - bf_hi(q.w); }
    }
}
__device__ __forceinline__ void pool_consume_any(GAS bf16_t* Pl, int tok0, int c8, int grp, const u32x4 (&w)[24]) {
    if (grp == 0) pool_consume<1>(Pl, tok0, c8, w); else if (grp == 1) pool_consume<2>(Pl, tok0, c8, w); else if (grp == 2) pool_consume<4>(Pl, tok0, c8, w); else pool_consume<8>(Pl, tok0, c8, w);
}
__device__ __forceinline__ void conv_issue(const GAS bf16_t* Z, const GAS bf16_t* Bv, const GAS float* wc, int tok0, int lane, u32x4 (&z)[10], u32x4 (&bb)[8], f32x4 (&wt)[6]) {
    const int s0 = tok0 & (S_ - 1);
    const GAS bf16_t* zp = Z + (size_t)tok0 * 512 + lane * 8; const GAS bf16_t* bp = Bv + (size_t)tok0 * 512 + lane * 8;
#pragma unroll
    for (int i = 0; i < 10; ++i) { const int sidx = s0 - 1 + i; z[i] = (u32x4){0u, 0u, 0u, 0u}; if (sidx >= 0 && sidx < S_) z[i] = *(const GAS u32x4*)(zp + (ptrdiff_t)(i - 1) * 512); }
#pragma unroll
    for (int j = 0; j < 8; ++j) bb[j] = *(const GAS u32x4*)(bp + (size_t)j * 512);
    wt[0] = *(const GAS f32x4*)(wc); wt[1] = *(const GAS f32x4*)(wc + 4); wt[2] = *(const GAS f32x4*)(wc + 512); wt[3] = *(const GAS f32x4*)(wc + 516); wt[4] = *(const GAS f32x4*)(wc + 1024); wt[5] = *(const GAS f32x4*)(wc + 1028);
}
__device__ __forceinline__ void conv_consume(GAS bf16_t* Bc, int tok0, int lane, const u32x4 (&z)[10], const u32x4 (&bb)[8], const f32x4 (&wt)[6]) {
    const f32x4 w0a = wt[0], w0b = wt[1], w1a = wt[2], w1b = wt[3], w2a = wt[4], w2b = wt[5];
    GAS bf16_t* op = Bc + (size_t)tok0 * 1024 + lane * 8;
#pragma unroll
    for (int j = 0; j < 8; ++j) { const u32x4 zm = z[j], zz = z[j + 1], zq = z[j + 2], b_ = bb[j];
        float h[8];
        h[0] = bf_lo(b_.x) * (w0a.x * bf_lo(zm.x) + w1a.x * bf_lo(zz.x) + w2a.x * bf_lo(zq.x));
        h[1] = bf_hi(b_.x) * (w0a.y * bf_hi(zm.x) + w1a.y * bf_hi(zz.x) + w2a.y * bf_hi(zq.x));
        h[2] = bf_lo(b_.y) * (w0a.z * bf_lo(zm.y) + w1a.z * bf_lo(zz.y) + w2a.z * bf_lo(zq.y));
        h[3] = bf_hi(b_.y) * (w0a.w * bf_hi(zm.y) + w1a.w * bf_hi(zz.y) + w2a.w * bf_hi(zq.y));
        h[4] = bf_lo(b_.z) * (w0b.x * bf_lo(zm.z) + w1b.x * bf_lo(zz.z) + w2b.x * bf_lo(zq.z));
        h[5] = bf_hi(b_.z) * (w0b.y * bf_hi(zm.z) + w1b.y * bf_hi(zz.z) + w2b.y * bf_hi(zq.z));
        h[6] = bf_lo(b_.w) * (w0b.z * bf_lo(zm.w) + w1b.z * bf_lo(zz.w) + w2b.z * bf_lo(zq.w));
        h[7] = bf_hi(b_.w) * (w0b.w * bf_hi(zm.w) + w1b.w * bf_hi(zz.w) + w2b.w * bf_hi(zq.w));
        u32x4 o; o.x = cvt_pk_bf16(h[0], h[1]); o.y = cvt_pk_bf16(h[2], h[3]); o.z = cvt_pk_bf16(h[4], h[5]); o.w = cvt_pk_bf16(h[6], h[7]);
        *(GAS u32x4*)(op + (size_t)j * 1024) = o; }
}
__device__ __forceinline__ int rowmap(int mode, int n) {
    if (mode == 0) return n;
    if (mode == 1) return ((n >> 7) << 8) + (n & 127);
    if (mode == 2) return ((n >> 7) << 8) + 128 + (n & 127);
    if (n < 1024 || n >= 2048) return n;
    if (n < 1536) { const int i = n - 1024; return 1024 + ((i >> 7) << 8) + (i & 127); }
    { const int i = n - 1536; return 1024 + ((i >> 7) << 8) + 128 + (i & 127); }
}
__device__ __forceinline__ void tr_item(const float* W_, int N, bf16_t* WT_, int ldt, const float* kgain_, const float* nscale_, int mode, int row_off, float* scr_, int item, int lane) {
    const GAS float* W = (const GAS float*)W_; GAS bf16_t* WT = (GAS bf16_t*)WT_; const GAS float* kgain = (const GAS float*)kgain_; const GAS float* nscale = (const GAS float*)nscale_;
    LAS float* scr = (LAS float*)scr_;
    const int nblk = N >> 5, kb = item / nblk, nb = item - kb * nblk, k0 = kb << 6, n0 = nb << 5;
    const int kr = lane >> 3, n4 = (lane & 7) * 4;
    f32x4 v[8]; float kg[8];
#pragma unroll
    for (int i = 0; i < 8; ++i) { v[i] = *(const GAS f32x4*)(W + (size_t)(k0 + kr + 8 * i) * N + n0 + n4); kg[i] = kgain_ ? kgain[k0 + kr + 8 * i] : 1.0f; }
#pragma unroll
    for (int i = 0; i < 8; ++i) { LAS float* d = scr + (kr + 8 * i) * 33 + n4; d[0] = v[i].x * kg[i]; d[1] = v[i].y * kg[i]; d[2] = v[i].z * kg[i]; d[3] = v[i].w * kg[i]; }
    asm volatile("s_waitcnt lgkmcnt(0)" ::: "memory");
    const int c = lane & 7;
#pragma unroll
    for (int j = 0; j < 4; ++j) { const int n = (lane >> 3) + 8 * j; const LAS float* sp = scr + (8 * c) * 33 + n; const float ns = nscale_ ? nscale[n0 + n] : 1.0f;
        u32x4 o; o.x = cvt_pk_bf16(sp[0 * 33] * ns, sp[1 * 33] * ns); o.y = cvt_pk_bf16(sp[2 * 33] * ns, sp[3 * 33] * ns); o.z = cvt_pk_bf16(sp[4 * 33] * ns, sp[5 * 33] * ns); o.w = cvt_pk_bf16(sp[6 * 33] * ns, sp[7 * 33] * ns);
        *(GAS u32x4*)(WT + (size_t)(row_off + rowmap(mode, n0 + n)) * ldt + k0 + 8 * c) = o; }
    asm volatile("s_waitcnt lgkmcnt(0)" ::: "memory");
}

__device__ __forceinline__ void phase_prep(const Params& p, unsigned char* ws, int bid, int nblk, int wid, int l, unsigned char* shm) {
    const int lane = fresh_lane(), wave = wid, tid = wid * 64 + lane;
    float* scr = (float*)shm + wave * (64 * 33);
    const int gw = bid * 8 + wave, NGW = nblk * 8;
    constexpr int I_FF = 16 * 88, I_IN = 16 * 176, I_CO = 8 * 32, I_O = 16 * 32, I_P = 2 * 8;
    constexpr int NITEMS = 6 * I_FF + I_IN + I_CO + I_O + 4 * I_P;
    const size_t oFF = (size_t)l * D_ * FF_;
    for (int it = gw; it < NITEMS; it += NGW) {
        int r = it;
        if (r < I_FF) { tr_item(inp(p, I_W1A) + oFF, FF_, (bf16_t*)(ws + W13A), D_, inp(p, I_GF1) + l * D_, nullptr, 1, 0, scr, r, lane); continue; } r -= I_FF;
        if (r < I_FF) { tr_item(inp(p, I_W3A) + oFF, FF_, (bf16_t*)(ws + W13A), D_, inp(p, I_GF1) + l * D_, nullptr, 2, 0, scr, r, lane); continue; } r -= I_FF;
        if (r < I_FF) { tr_item(inp(p, I_W2A) + oFF, D_, (bf16_t*)(ws + W2A), FF_, nullptr, nullptr, 0, 0, scr, r, lane); continue; } r -= I_FF;
        if (r < I_FF) { tr_item(inp(p, I_W1B) + oFF, FF_, (bf16_t*)(ws + W13B), D_, inp(p, I_GF2) + l * D_, nullptr, 1, 0, scr, r, lane); continue; } r -= I_FF;
        if (r < I_FF) { tr_item(inp(p, I_W3B) + oFF, FF_, (bf16_t*)(ws + W13B), D_, inp(p, I_GF2) + l * D_, nullptr, 2, 0, scr, r, lane); continue; } r -= I_FF;
        if (r < I_FF) { tr_item(inp(p, I_W2B) + oFF, D_, (bf16_t*)(ws + W2B), FF_, nullptr, nullptr, 0, 0, scr, r, lane); continue; } r -= I_FF;
        if (r < I_IN) { tr_item(inp(p, I_WIN) + (size_t)l * D_ * INW_, INW_, (bf16_t*)(ws + WIN), D_, inp(p, I_GMIX) + l * D_, nullptr, 3, 0, scr, r, lane); continue; } r -= I_IN;
        if (r < I_CO) { tr_item(inp(p, I_WCONVOUT) + (size_t)l * 512 * D_, D_, (bf16_t*)(ws + WCO), 512, nullptr, nullptr, 0, 0, scr, r, lane); continue; } r -= I_CO;
        if (r < I_O) { tr_item(inp(p, I_WO) + (size_t)l * D_ * D_, D_, (bf16_t*)(ws + WO), D_, nullptr, nullptr, 0, 0, scr, r, lane); continue; } r -= I_O;
        { const int g = r / I_P; r -= g * I_P;
          tr_item(inp(p, I_WPOOL) + ((size_t)l * 4 + g) * 128 * 256, 256, (bf16_t*)(ws + WP), 512, nullptr, inp(p, I_PSCALE) + l * D_ + g * 256, 0, g * 256, scr, r, lane); }
    }
    __syncthreads();
    float* ct = (float*)shm;
    if (tid < 128) ct[tid] = cospif((float)tid * (1.0f / 64.0f));
    __syncthreads();
    const float* wf = inp(p, I_WFOUR) + (size_t)l * 4 * 128 * 256;
    bf16_t* WFo = (bf16_t*)(ws + WF);
    for (int idx = bid * 512 + tid; idx < 4 * 256 * 256; idx += nblk * 512) {
        const int d = idx & 255, kc = (idx >> 8) & 255, g = idx >> 16, c = ((kc >> 3) << 2) + (kc & 3), isq = (kc >> 2) & 1, sh = isq ? 96 : 0;
        const float* w = wf + (size_t)g * 128 * 256 + d;
        float a = 0.f;
#pragma unroll 8
        for (int j = 0; j < 128; ++j) a += ct[(j * c + sh) & 127] * w[j * 256];
        if (isq) a = -a;
        WFo[(size_t)(g * 256 + d) * 512 + kc] = (bf16_t)(cvt_pk_bf16(a * (1.0f / 1024.0f), 0.f) & 0xffffu);
    }
    __syncthreads();
}

__device__ __forceinline__ void phase_norm(int bid, int nblk, int wid, const float* x, bf16_t* xb, float* r) {
    const int lane = fresh_lane(), gw = bid * 8 + wid, NGW = nblk * 8;
    for (int row = gw; row < T_; row += NGW) {
        const GAS f32x4* xr = (const GAS f32x4*)(x + (size_t)row * D_) + lane;
        f32x4 v[4]; float s = 0.f;
#pragma unroll
        for (int j = 0; j < 4; ++j) { v[j] = xr[64 * j]; s += (v[j].x * v[j].x + v[j].y * v[j].y) + (v[j].z * v[j].z + v[j].w * v[j].w); }
        s = wave_sum(s, lane);
        if (lane < 4) *(GAS float*)(r + (size_t)row * 4 + lane) = lane == 0 ? s : 0.f;
        GAS u32x2* o = (GAS u32x2*)(xb + (size_t)row * D_) + lane;
#pragma unroll
        for (int j = 0; j < 4; ++j) o[64 * j] = (u32x2){cvt_pk_bf16(v[j].x, v[j].y), cvt_pk_bf16(v[j].z, v[j].w)};
    }
}
__device__ __forceinline__ void phase_final(int bid, int nblk, int wid, const bf16_t* xb, float* out, const float* g, const float* ssp) {
    const int lane = fresh_lane(), gw = bid * 8 + wid, NGW = nblk * 8;
    for (int row = gw; row < T_; row += NGW) {
        const GAS u32x2* xr = (const GAS u32x2*)(xb + (size_t)row * D_) + lane;
        u32x2 v[4];
#pragma unroll
        for (int j = 0; j < 4; ++j) v[j] = xr[64 * j];
        const float rs = row_rs(ssp, row);
        GAS f32x4* o = (GAS f32x4*)(out + (size_t)row * D_) + lane;
#pragma unroll
        for (int j = 0; j < 4; ++j) { const f32x4 gg = ((const GAS f32x4*)g)[lane + 64 * j];
            o[64 * j] = (f32x4){bf_lo(v[j].x) * rs * gg.x, bf_hi(v[j].x) * rs * gg.y, bf_lo(v[j].y) * rs * gg.z, bf_hi(v[j].y) * rs * gg.w}; }
    }
}

__device__ __forceinline__ void phase_mix(const Params& p, unsigned char* ws, int bid, int nblk, int wid, int l, unsigned char* shm) {
    const int lane = fresh_lane(), tid0 = wid * 64 + lane;
    const GAS bf16_t* Uq = (const GAS bf16_t*)(ws + WS_P1);
    const GAS bf16_t* Bv = Uq + (size_t)T_ * 512; const GAS bf16_t* Z = Bv + (size_t)T_ * 512; const GAS bf16_t* Pu = Z + (size_t)T_ * 512;
    GAS bf16_t* PQ = (GAS bf16_t*)(ws + WS_XB);
    GAS bf16_t* Pl = (GAS bf16_t*)(ws + WS_P2); GAS bf16_t* Bc = Pl + 512;
    c2* X = (c2*)shm;
    TwHw tw;
    const int gw = bid * 8 + wid, NGW = nblk * 8;
    int ptask = gw, ctask = gw;
    int slot = 0;
    u32x4 v[8];
    if (bid < 512) { int tidp = tid0; asm volatile("" : "+v"(tidp)); const GAS u32x4* src0 = (const GAS u32x4*)(Uq + (size_t)bid * S_ * 4);
#pragma unroll
        for (int it = 0; it < 8; ++it) v[it] = src0[tidp + 512 * it]; }
    for (int item = bid; item < 512; item += nblk) {
        const int b = item >> 7, q = item & 127;
        int tidi = tid0; asm volatile("" : "+v"(tidi));
#pragma unroll
        for (int it = 0; it < 8; ++it) { const int i = tidi + 512 * it;
            X[2 * i] = c2{bf_lo(v[it].x), bf_hi(v[it].x)}; X[8192 + 2 * i] = c2{bf_lo(v[it].y), bf_hi(v[it].y)};
            X[2 * i + 1] = c2{bf_lo(v[it].z), bf_hi(v[it].z)}; X[8192 + 2 * i + 1] = c2{bf_lo(v[it].w), bf_hi(v[it].w)}; }
        __syncthreads();
#pragma unroll 1
        for (int sg = 0; sg < 7; ++sg, ++slot) {
            int tid = tid0; asm volatile("" : "+v"(tid));
            const bool do_pool = !(slot & 1) && ptask < 4096, do_conv = (slot & 1) && ctask < T_ / 8;
            if (do_pool) {
                const int grp = ptask & 3, chunk = (ptask >> 2) * 4 + (lane >> 4), c8 = grp * 16 + (lane & 15), tok0 = chunk * 8;
                u32x4 w[24]; pool_issue((const GAS bf16_t*)(ws + WS_P1) + (size_t)T_ * 1536, tok0, c8, 1 << grp, w);
                if (sg < 6) fft_r4_stage(X, tid, 11 - 2 * sg, tw); else fft_r2_last(X, tid);
                __syncthreads();
                pool_consume_any((GAS bf16_t*)(ws + WS_P2), tok0, c8, grp, w); ptask += NGW;
            } else if (do_conv) {
                const int tok0 = ctask * 8;
                u32x4 z[10], bb[8]; f32x4 wt[6];
                conv_issue((const GAS bf16_t*)(ws + WS_P1) + (size_t)T_ * 1024, (const GAS bf16_t*)(ws + WS_P1) + (size_t)T_ * 512, (const GAS float*)(inp(p, I_WCONV) + (size_t)l * 3 * 512) + lane * 8, tok0, lane, z, bb, wt);
                if (sg < 6) fft_r4_stage(X, tid, 11 - 2 * sg, tw); else fft_r2_last(X, tid);
                __syncthreads();
                conv_consume((GAS bf16_t*)(ws + WS_P2) + 512, tok0, lane, z, bb, wt); ctask += NGW;
            } else {
                if (sg < 6) fft_r4_stage(X, tid, 11 - 2 * sg, tw); else fft_r2_last(X, tid);
                __syncthreads();
            }
        }
        int tido = tid0; asm volatile("" : "+v"(tido));
        { const int nit = item + nblk < 512 ? item + nblk : item;
          const GAS u32x4* srcn = (const GAS u32x4*)(Uq + (size_t)nit * S_ * 4);
#pragma unroll
          for (int it = 0; it < 8; ++it) v[it] = srcn[tido + 512 * it]; }
        GAS bf16_t* dst = PQ + (size_t)item * S_ * 8;
#pragma unroll 4
        for (int it = 0; it < 16; ++it) { const int k = tido + 512 * it; const int p0 = fft_pos(k), p1 = fft_pos((S_ - k) & (S_ - 1));
            const c2 z0 = X[p0], w0 = X[p1], z1 = X[8192 + p0], w1 = X[8192 + p1];
            const float P0 = 0.5f * (z0.x + w0.x), Q0 = 0.5f * (w0.y - z0.y), P1 = 0.5f * (z0.y + w0.y), Q1 = 0.5f * (z0.x - w0.x);
            const float P2 = 0.5f * (z1.x + w1.x), Q2 = 0.5f * (w1.y - z1.y), P3 = 0.5f * (z1.y + w1.y), Q3 = 0.5f * (z1.x - w1.x);
            GAS bf16_t* d = dst + (size_t)k * 8;
            *(GAS u32x4*)d = (u32x4){cvt_pk_bf16(P0, P1), cvt_pk_bf16(P2, P3), cvt_pk_bf16(Q0, Q1), cvt_pk_bf16(Q2, Q3)}; }
        __syncthreads();
    }
    const int lane2 = fresh_lane();
    for (; ptask < 4096; ptask += NGW) {
        const int grp = ptask & 3, chunk = (ptask >> 2) * 4 + (lane2 >> 4), c8 = grp * 16 + (lane2 & 15), tok0 = chunk * 8;
        u32x4 w[24]; pool_issue(Pu, tok0, c8, 1 << grp, w); pool_consume_any(Pl, tok0, c8, grp, w);
    }
    for (; ctask < T_ / 8; ctask += NGW) {
        const int tok0 = ctask * 8;
        u32x4 z[10], bb[8]; f32x4 wt[6]; conv_issue(Z, Bv, (const GAS float*)(inp(p, I_WCONV) + (size_t)l * 3 * 512) + lane2 * 8, tok0, lane2, z, bb, wt); conv_consume(Bc, tok0, lane2, z, bb, wt);
    }
}

#define XB_TMO      128
#define XB_XCNT(j)  (256  + 64 * (j))
#define XB_XSUB(j)  (1280 + 64 * (j))
#define XB_XGEN(j)  (2304 + 64 * (j))
#define XB_TOP      3328
#define XB_TOPGEN   3392
#define XCD_BAR_WORDS 3456
#define XB_SPIN_CAP (1u << 18)
__device__ __forceinline__ unsigned xb_ld(unsigned* p)              { return __hip_atomic_load(p, __ATOMIC_RELAXED, __HIP_MEMORY_SCOPE_AGENT); }
__device__ __forceinline__ unsigned xb_add(unsigned* p, unsigned v) { return __hip_atomic_fetch_add(p, v, __ATOMIC_RELAXED, __HIP_MEMORY_SCOPE_AGENT); }
__device__ __forceinline__ unsigned xb_xcc_id() { return (unsigned)__builtin_amdgcn_s_getreg((3 << 11) | 20) & 0xFu; }
#define XB_SPIN(cond, bar) do { unsigned _sp = 0; while (cond) { __builtin_amdgcn_s_sleep(1); \
    if ((++_sp & 255u) == 0u) { if (xb_ld(&(bar)[XB_TMO])) break; if (_sp > XB_SPIN_CAP) { atomicAdd(&(bar)[XB_TMO], 1u); break; } } } } while (0)
__device__ __forceinline__ void xcd_barrier_complete(unsigned* bar, unsigned x, unsigned G, unsigned& nloc, unsigned& nx) {
    unsigned sum, cnt, mine, sp = 0u;
    for (;;) {
        sum = 0u; cnt = 0u; mine = 0u;
#pragma unroll
        for (unsigned j = 0; j < 16; ++j) { const unsigned c = xb_ld(&bar[XB_XCNT(j)]); sum += c; cnt += (c > 0u) ? 1u : 0u; mine = (j == x) ? c : mine; }
        if (sum == G) break;
        __builtin_amdgcn_s_sleep(1);
        if ((++sp & 255u) == 0u) { if (xb_ld(&bar[XB_TMO])) break; if (sp > XB_SPIN_CAP) { atomicAdd(&bar[XB_TMO], 1u); break; } }
    }
    nloc = mine > 0u ? mine : 1u; nx = cnt > 0u ? cnt : 1u;
}
__device__ __forceinline__ void xcd_barrier(unsigned* bar, volatile unsigned* st, bool leader, unsigned G) {
    asm volatile("s_waitcnt vmcnt(0)" ::: "memory");
    __syncthreads();
    if (leader) {
        const unsigned x = xb_xcc_id();
        __builtin_amdgcn_s_waitcnt(0);
        unsigned nloc = st[0], nx = st[1];
        if (nloc == 0u) { xcd_barrier_complete(bar, x, G, nloc, nx); st[0] = nloc; st[1] = nx; }
        const unsigned old = xb_add(&bar[XB_XSUB(x)], 1u);
        const unsigned gen = old / nloc;
        if (old + 1u == (gen + 1u) * nloc) {
            __builtin_amdgcn_fence(__ATOMIC_RELEASE, "agent");
            asm volatile("s_waitcnt vmcnt(0)" ::: "memory");
            const unsigned og = xb_add(&bar[XB_TOP], 1u);
            const unsigned tg = og / nx;
            if (og + 1u == (tg + 1u) * nx) xb_add(&bar[XB_TOPGEN], 1u);
            else XB_SPIN(xb_ld(&bar[XB_TOPGEN]) == tg, bar);
            __builtin_amdgcn_fence(__ATOMIC_ACQUIRE, "agent");
            xb_add(&bar[XB_XGEN(x)], 1u);
            asm volatile("s_waitcnt vmcnt(0)" ::: "memory");
        } else {
            XB_SPIN(xb_ld(&bar[XB_XGEN(x)]) == gen, bar);
            __builtin_amdgcn_fence(__ATOMIC_ACQUIRE, "agent");
            asm volatile("s_waitcnt vmcnt(0)" ::: "memory");
        }
    }
    __syncthreads();
}

constexpr int PH_PER_LAYER = 9, N_PHASES = DEPTH_ * PH_PER_LAYER + 1;

__device__ __forceinline__ void run_phase(const Params& p, int ph, int wid, unsigned char* shm) {
    unsigned char* ws = p.ws; float* X = p.out; int bid = blockIdx.x, nblk = gridDim.x;
    asm volatile("" : "+s"(ws), "+s"(X), "+s"(bid), "+s"(nblk), "+s"(wid));
    LAS unsigned char* lds = (LAS unsigned char*)shm;
    bf16_t* XB = (bf16_t*)(ws + WS_XB); bf16_t* BIG = (bf16_t*)(ws + WS_BIG);
    bf16_t* P1 = (bf16_t*)(ws + WS_P1); bf16_t* P2 = (bf16_t*)(ws + WS_P2);
    StaticOrder S;
    float* SSP = (float*)(ws + WS_SSP);
    bf16_t* XR = (bf16_t*)X;
    if (ph == N_PHASES - 1) { phase_final(bid, nblk, wid, P2, X, inp(p, I_GFINAL), SSP); return; }
    const int l = ph / PH_PER_LAYER, sp = ph - l * PH_PER_LAYER;
    switch (sp) {
    case 0: phase_prep(p, ws, bid, nblk, wid, l, shm); if (l == 0) phase_norm(bid, nblk, wid, inp(p, I_X), XR, SSP); break;
    case 1: case 7: { Gemm g{XR, (const bf16_t*)(ws + (sp == 1 ? W13A : W13B)), D_, D_, D_, T_, INW_, 0}; S.init(T_, INW_, nblk, bid);
        EpiSwiglu E{BIG, SSP, (const LAS float*)(lds + LDS_RS)}; gemm_phase(lds, g, S, E, wid); } break;
    case 2: case 8: { Gemm g{BIG, (const bf16_t*)(ws + (sp == 2 ? W2A : W2B)), FF_, FF_, FF_, T_, D_, 0}; S.init(T_, D_, nblk, bid);
        EpiResid E{XR, (sp == 8 && l == DEPTH_ - 1) ? P2 : XR, SSP, 0.5f, (LAS float*)(lds + LDS_RED)}; gemm_phase(lds, g, S, E, wid); } break;
    case 3: { Gemm g{XR, (const bf16_t*)(ws + WIN), D_, D_, D_, T_, INW_, 0}; S.init(T_, INW_, nblk, bid);
        EpiIn E{P1, P1 + (size_t)T_ * 512, P1 + (size_t)T_ * 1024, P1 + (size_t)T_ * 1536, BIG, SSP, (const LAS float*)(lds + LDS_RS)}; gemm_phase(lds, g, S, E, wid); } break;
    case 4: phase_mix(p, ws, bid, nblk, wid, l, shm); break;
    case 5: { S.init(T_, D_, nblk, bid);
        MergeOps g{XB, P2, (const bf16_t*)(ws + WF)}; EpiMergeSeg E{P1, BIG}; gemm_merge_phase(lds, g, S, E, wid); } break;
    case 6: { Gemm g{P1, (const bf16_t*)(ws + WO), D_, D_, D_, T_, D_, 0}; S.init(T_, D_, nblk, bid);
        EpiResid E{XR, XR, SSP, 1.0f, (LAS float*)(lds + LDS_RED)}; gemm_phase(lds, g, S, E, wid); } break;
    }
}

__global__ __launch_bounds__(512, 2) void mega(Params p) {
    extern __shared__ __attribute__((aligned(16))) unsigned char shm[];
    cg::grid_group grid = cg::this_grid();
    const int wid = __builtin_amdgcn_readfirstlane(threadIdx.x >> 6);
    volatile unsigned* st = (volatile unsigned*)(shm + STAGE_BYTES);
    if (threadIdx.x == 0) {
#pragma unroll
        for (int i = 0; i < 18; ++i) *(volatile LAS unsigned long long*)((LAS unsigned char*)shm + LDS_TBL + 8 * i) = (unsigned long long)p.in[i];
    }
    __syncthreads();
    if (p.coop) {
        if (wid == 0 && fresh_lane() == 0) { st[0] = 0u; st[1] = 0u; (void)xb_add(&((unsigned*)(p.ws + WS_BAR))[XB_XCNT(xb_xcc_id())], 1u); }
        __syncthreads();
    }
    for (int ph = p.ph_lo; ph < p.ph_hi; ++ph) {
        run_phase(p, ph, wid, shm);
        if (p.coop && ph + 1 < p.ph_hi) {
            if (p.ph_lo < 0) grid.sync();
            else { unsigned* bar = (unsigned*)(p.ws + WS_BAR); asm volatile("" : "+s"(bar)); const bool leader = (wid == 0) && (fresh_lane() == 0); xcd_barrier(bar, st, leader, gridDim.x); }
        }
    }
}

#ifndef MK_MULTI
#define MK_MULTI 0
#endif
extern "C" void kernel_launch(void* const* d_in, const int* in_sizes, int n_in, void* d_out, int out_size, void* d_ws, size_t ws_size, hipStream_t stream) {
    static int grid = 0;
    constexpr int LDS_BYTES = STAGE_BYTES + 256 + 4096 + 4096;
    if (grid == 0) {
        if (ws_size < WS_END) { fprintf(stderr, "kernel_launch: workspace too small: %zu < %zu\n", ws_size, (size_t)WS_END); grid = -1; return; }
        int dev = 0, cus = 0, per_cu = 0;
        hipGetDevice(&dev); hipDeviceGetAttribute(&cus, hipDeviceAttributeMultiprocessorCount, dev);
        if (hipFuncSetAttribute((const void*)mega, hipFuncAttributeMaxDynamicSharedMemorySize, LDS_BYTES) != hipSuccess) { fprintf(stderr, "kernel_launch: hipFuncSetAttribute failed\n"); }
        hipOccupancyMaxActiveBlocksPerMultiprocessor(&per_cu, (const void*)mega, 512, LDS_BYTES);
        (void)hipGetLastError();
        if (per_cu < 1) per_cu = 1;
        grid = cus;
        fprintf(stderr, "kernel_launch: cus %d per_cu %d grid %d ws %zu need %zu\n", cus, per_cu, grid, ws_size, (size_t)WS_END);
    }
    if (grid < 0) return;
    if (hipMemsetAsync((char*)d_ws + WS_BAR, 0, XCD_BAR_WORDS * 4, stream) != hipSuccess) { fprintf(stderr, "kernel_launch: memset failed\n"); return; }
    Params p{};
    for (int i = 0; i < 18; ++i) p.in[i] = (const float*)d_in[i];
    p.out = (float*)d_out; p.ws = (unsigned char*)d_ws;
#if MK_MULTI
    for (int ph = 0; ph < N_PHASES; ++ph) { p.ph_lo = ph; p.ph_hi = ph + 1; p.coop = 0; hipLaunchKernelGGL(mega, dim3(grid), dim3(512), LDS_BYTES, stream, p); }
#else
    p.ph_lo = 0; p.ph_hi = N_PHASES; p.coop = 1;
    void* args[] = {&p};
    hipError_t e = hipLaunchCooperativeKernel((const void*)mega, dim3(grid), dim3(512), args, LDS_BYTES, stream);
    if (e != hipSuccess) fprintf(stderr, "cooperative launch failed: %s (grid %d)\n", hipGetErrorString(e), grid);
#endif
}
```

```cpp
#include <hip/hip_runtime.h>
#include <hip/hip_cooperative_groups.h>
#include <cstdio>
namespace cg = cooperative_groups;

#define LAS __attribute__((address_space(3)))
#define GAS __attribute__((address_space(1)))
typedef unsigned short bf16_t;
typedef short bf16x8 __attribute__((ext_vector_type(8)));
typedef float f32x4 __attribute__((ext_vector_type(4)));
typedef unsigned u32x4 __attribute__((ext_vector_type(4)));
typedef unsigned u32x2 __attribute__((ext_vector_type(2)));

constexpr int T_ = 32768, D_ = 1024, FF_ = 2816, S_ = 8192, INW_ = 5632, DEPTH_ = 4;
constexpr float EPS_ = 1e-6f;

constexpr size_t WS_BAR = 192 * 1024;
constexpr size_t WS_SSP = 1 << 20;
constexpr size_t WS_W = 3 << 20;
constexpr size_t W13A = WS_W;
constexpr size_t W2A = W13A + (size_t)INW_ * D_ * 2;
constexpr size_t WIN = W2A + (size_t)D_ * FF_ * 2;
constexpr size_t WF = WIN + (size_t)INW_ * D_ * 2;
constexpr size_t WP = WF + (size_t)1024 * 512 * 2;
constexpr size_t WCO = WP + (size_t)1024 * 512 * 2;
constexpr size_t WO = WCO + (size_t)1024 * 512 * 2;
constexpr size_t W13B = WO + (size_t)1024 * 1024 * 2;
constexpr size_t W2B = W13B + (size_t)INW_ * D_ * 2;
constexpr size_t WEND = W2B + (size_t)D_ * FF_ * 2;
constexpr size_t WS_XB = (WEND + 4095) & ~(size_t)4095;
constexpr size_t WS_BIG = WS_XB + (size_t)T_ * 1024 * 2;
constexpr size_t WS_P1 = WS_BIG + (size_t)T_ * 3072 * 2;
constexpr size_t WS_P2 = WS_P1 + (size_t)T_ * 2048 * 2;
constexpr size_t WS_END = WS_P2 + (size_t)T_ * 1024 * 2;

struct Params {
    const float* in[18];
    float* out; unsigned char* ws;
    int ph_lo, ph_hi, coop, pad;
};
enum { I_X = 0, I_GF1, I_W1A, I_W3A, I_W2A, I_GMIX, I_WIN, I_WFOUR, I_WCONV, I_WCONVOUT, I_WPOOL, I_PSCALE, I_WO, I_GF2, I_W1B, I_W3B, I_W2B, I_GFINAL };

constexpr int LDS_RS = 8 * 128 * 64 * 2 + 256 + 4096;
constexpr int LDS_RED = 8 * 128 * 64 * 2 + 256;
constexpr int LDS_TBL = 8 * 128 * 64 * 2 + 64;
#define inp(p, i) lds_ptr(shm, (i))
__device__ __forceinline__ const float* lds_ptr(const unsigned char* shm, int i) {
    const unsigned long long v = *(const volatile LAS unsigned long long*)((const LAS unsigned char*)shm + LDS_TBL + 8 * i);
    const unsigned lo = __builtin_amdgcn_readfirstlane((unsigned)v), hi = __builtin_amdgcn_readfirstlane((unsigned)(v >> 32));
    return (const float*)(((unsigned long long)hi << 32) | lo);
}
__device__ __forceinline__ unsigned cvt_pk_bf16(float lo, float hi) { unsigned r; asm volatile("v_cvt_pk_bf16_f32 %0, %1, %2" : "=v"(r) : "v"(lo), "v"(hi)); return r; }
__device__ __forceinline__ unsigned pack_u8x4(float a, float b, float c, float d) {
    unsigned r = 0u; r = __builtin_amdgcn_cvt_pk_u8_f32(a, 0u, r); r = __builtin_amdgcn_cvt_pk_u8_f32(b, 1u, r); r = __builtin_amdgcn_cvt_pk_u8_f32(c, 2u, r); r = __builtin_amdgcn_cvt_pk_u8_f32(d, 3u, r); return r;
}
__device__ __forceinline__ float ubf(unsigned w, int k) { return (float)((w >> (8 * k)) & 0xffu); }
__device__ __forceinline__ float bf_lo(unsigned w) { return __uint_as_float(w << 16); }
__device__ __forceinline__ float bf_hi(unsigned w) { return __uint_as_float(w & 0xffff0000u); }
__device__ __forceinline__ int fresh_lane() { int z; asm volatile("v_mov_b32 %0, 0" : "=v"(z)); return (int)__builtin_amdgcn_mbcnt_hi(~0u, __builtin_amdgcn_mbcnt_lo(~0u, (unsigned)z)); }
__device__ __forceinline__ float row_rs(const float* ssp, int row) {
    const f32x4 a = *(const f32x4*)(ssp + (size_t)row * 4);
    return 1.0f / sqrtf(((a.x + a.y) + (a.z + a.w)) * (1.0f / D_) + EPS_);
}
__device__ __forceinline__ float lds_rs(const LAS float* rsl, int rl) {
    const f32x4 a = *(const LAS f32x4*)(rsl + rl * 4);
    return __builtin_amdgcn_rsqf(((a.x + a.y) + (a.z + a.w)) * (1.0f / D_) + EPS_);
}
__device__ __forceinline__ float bperm(float v, int srclane) { return __int_as_float(__builtin_amdgcn_ds_bpermute(srclane << 2, __float_as_int(v))); }
__device__ __forceinline__ float wave_sum(float v, int lane) {
#pragma unroll
    for (int o = 1; o < 64; o <<= 1) v += bperm(v, lane ^ o);
    return v;
}

constexpr int BM = 256, BK = 64, HALF = 128, HTB = HALF * BK * 2, STAGE_BYTES = 8 * HTB, NXCD = 8, WGM = 8;
__host__ __device__ __forceinline__ int lds_byte(int r, int c) { const int st = (r >> 4) * 2 + (c >> 5), rr = r & 15, cc = c & 31, ob = rr * 64 + cc * 2; return st * 1024 + (ob ^ (((ob >> 9) & 1) << 5)); }
__host__ __device__ __forceinline__ void stage_rc(int b, int& R, int& C) { const int st = b / 1024, sb = b % 1024, swz = sb ^ (((sb >> 9) & 1) << 5); R = (st >> 1) * 16 + swz / 64; C = (st & 1) * 32 + (swz % 64) / 2; }
__host__ __device__ __forceinline__ int perm32(int rho) { const int n = rho >> 4, i = rho & 15; return 8 * (i >> 2) + 4 * n + (i & 3); }

struct Unit { int pm, pn, seg; };
struct Gemm { const bf16_t* A; const bf16_t* Bt; int lda, ldb, K, M, N, acs; };
struct StaticOrder {
    int nM, nN, nwg, G, c;
    __device__ void init(int M, int N, int G_, int c_) { nM = M / BM; nN = N / BM; nwg = nM * nN; G = G_; c = c_; }
    __device__ bool next(int i, Unit& u) const {
        const long L = (long)i * G + c; if (L >= nwg) return false;
        int wgid = (int)L; { const int q = nwg / NXCD, r = nwg % NXCD, xcd = wgid % NXCD, off = wgid / NXCD; wgid = (xcd < r ? xcd * (q + 1) : r * (q + 1) + (xcd - r) * q) + off; }
        const int nig = WGM * nN, gid = wgid / nig, fm = gid * WGM, gsz = (nM - fm) < WGM ? (nM - fm) : WGM;
        u.pm = fm + ((wgid % nig) % gsz); u.pn = (wgid % nig) / gsz; return true;
    }
};

typedef f32x4 Acc[2][2][4][2];

struct EpiSwiglu {
    static constexpr bool PERM = true, PREFETCH = true;
    bf16_t* H; const float* r; const LAS float* rsl;
    __device__ __forceinline__ void operator()(const Acc& acc, const Unit& u, int wr, int wc, int fr, int fq) const {
        const int rl0 = wr * 64 + fr, row0 = u.pm * BM + rl0, col0 = u.pn * 128 + wc * 32 + 8 * fq;
#pragma unroll
        for (int ai = 0; ai < 2; ++ai)
#pragma unroll
            for (int m = 0; m < 4; ++m) {
                const int row = row0 + ai * HALF + m * 16; const float rs = lds_rs(rsl, rl0 + ai * HALF + m * 16);
                float a[8], b[8], e[8];
#pragma unroll
                for (int j = 0; j < 8; ++j) { a[j] = acc[ai][0][m][j >> 2][j & 3] * rs; b[j] = acc[ai][1][m][j >> 2][j & 3] * rs; e[j] = a[j] * -1.4426950408889634f; }
                __builtin_amdgcn_sched_barrier(0);
#pragma unroll
                for (int j = 0; j < 8; ++j) e[j] = __builtin_amdgcn_exp2f(e[j]);
                __builtin_amdgcn_sched_barrier(0);
#pragma unroll
                for (int j = 0; j < 8; ++j) { e[j] = e[j] + 1.0f; b[j] = a[j] * b[j]; }
                __builtin_amdgcn_sched_barrier(0);
#pragma unroll
                for (int j = 0; j < 8; ++j) e[j] = __builtin_amdgcn_rcpf(e[j]);
                __builtin_amdgcn_sched_barrier(0);
#pragma unroll
                for (int j = 0; j < 8; ++j) e[j] = e[j] * b[j];
                u32x4 w; w.x = cvt_pk_bf16(e[0], e[1]); w.y = cvt_pk_bf16(e[2], e[3]); w.z = cvt_pk_bf16(e[4], e[5]); w.w = cvt_pk_bf16(e[6], e[7]);
                *(GAS u32x4*)(H + (size_t)row * FF_ + col0) = w;
            }
    }
};
struct EpiResid {
    static constexpr bool PERM = true, PREFETCH = false;
    const bf16_t* XR; bf16_t* XO; float* SSP; float scale; LAS float* red;
    __device__ __forceinline__ void operator()(const Acc& acc, const Unit& u, int wr, int wc, int fr, int fq) const {
        const int row0 = u.pm * BM + wr * 64 + fr, col0 = u.pn * BM + wc * 32 + 8 * fq;
        const GAS bf16_t* xbase = (const GAS bf16_t*)XR + (size_t)row0 * D_ + col0; GAS bf16_t* obase = (GAS bf16_t*)XO + (size_t)row0 * D_ + col0;
        u32x4 xv[4][2];
#define RS_LOAD(s) do { const GAS bf16_t* rp_ = xbase + (size_t)((((s) >> 2) * HALF) + ((s) & 3) * 16) * D_; \
        xv[(s) & 3][0] = *(const GAS u32x4*)(rp_); xv[(s) & 3][1] = *(const GAS u32x4*)(rp_ + HALF); } while (0)
        RS_LOAD(0); RS_LOAD(1); RS_LOAD(2); RS_LOAD(3);
        const int l0 = fq * 16 + fr;
#pragma unroll
        for (int st = 0; st < 8; ++st) {
            const int ai = st >> 2, m = st & 3; const size_t ro = (size_t)(ai * HALF + m * 16) * D_;
            float sq = 0.f;
#pragma unroll
            for (int bj = 0; bj < 2; ++bj) { const u32x4 xo = xv[st & 3][bj]; const f32x4 a0 = acc[ai][bj][m][0], a1 = acc[ai][bj][m][1];
                const float v0 = bf_lo(xo.x) + a0.x * scale, v1 = bf_hi(xo.x) + a0.y * scale, v2 = bf_lo(xo.y) + a0.z * scale, v3 = bf_hi(xo.y) + a0.w * scale;
                const float v4 = bf_lo(xo.z) + a1.x * scale, v5 = bf_hi(xo.z) + a1.y * scale, v6 = bf_lo(xo.w) + a1.z * scale, v7 = bf_hi(xo.w) + a1.w * scale;
                sq += ((v0 * v0 + v1 * v1) + (v2 * v2 + v3 * v3)) + ((v4 * v4 + v5 * v5) + (v6 * v6 + v7 * v7));
                *(GAS u32x4*)(obase + ro + bj * HALF) = (u32x4){cvt_pk_bf16(v0, v1), cvt_pk_bf16(v2, v3), cvt_pk_bf16(v4, v5), cvt_pk_bf16(v6, v7)}; }
            if (st + 4 < 8) { RS_LOAD(st + 4); }
            sq += bperm(sq, l0 ^ 16); sq += bperm(sq, l0 ^ 32);
            if (fq == 0) red[(ai * HALF + wr * 64 + m * 16 + fr) * 4 + wc] = sq;
        }
#undef RS_LOAD
        asm volatile("s_waitcnt lgkmcnt(0)" ::: "memory");
        __builtin_amdgcn_s_barrier(); __builtin_amdgcn_s_barrier();
        asm volatile("" ::: "memory");
        if (l0 < 32) { const int rl = (wr * 4 + wc) * 32 + l0; const f32x4 t = *(const LAS f32x4*)(red + rl * 4);
            *(GAS float*)(SSP + (size_t)(u.pm * BM + rl) * 4 + u.pn) = (t.x + t.y) + (t.z + t.w); }
    }
};
struct EpiIn {
    static constexpr bool PERM = true, PREFETCH = true;
    bf16_t *Uq, *Bv, *Z, *Pu, *Gt; const float* r; const LAS float* rsl;
    __device__ __forceinline__ void operator()(const Acc& acc, const Unit& u, int wr, int wc, int fr, int fq) const {
        const int rl0 = wr * 64 + fr, row0 = u.pm * BM + rl0, cw = wc * 32 + 8 * fq; const int pn = u.pn;
#pragma unroll
        for (int ai = 0; ai < 2; ++ai)
#pragma unroll
            for (int m = 0; m < 4; ++m) {
                const int row = row0 + ai * HALF + m * 16; const float rs = lds_rs(rsl, rl0 + ai * HALF + m * 16);
                if (pn >= 4 && pn < 8) {
                    float h[8];
#pragma unroll
                    for (int n = 0; n < 2; ++n)
#pragma unroll
                        for (int j = 0; j < 4; ++j) h[4 * n + j] = (acc[ai][0][m][n][j] * rs) * (acc[ai][1][m][n][j] * rs);
                    u32x4 w; w.x = cvt_pk_bf16(h[0], h[1]); w.y = cvt_pk_bf16(h[2], h[3]); w.z = cvt_pk_bf16(h[4], h[5]); w.w = cvt_pk_bf16(h[6], h[7]);
                    *(GAS u32x4*)(Z + (size_t)row * 512 + (pn - 4) * 128 + cw) = w;
                } else {
                    u32x2 g0 = (u32x2){0u, 0u};
#pragma unroll
                    for (int bj = 0; bj < 2; ++bj) {
                        float h[8];
#pragma unroll
                        for (int n = 0; n < 2; ++n)
#pragma unroll
                            for (int j = 0; j < 4; ++j) h[4 * n + j] = acc[ai][bj][m][n][j] * rs;
                        if (pn >= 10) {
#pragma unroll
                            for (int j = 0; j < 8; ++j) h[j] = h[j] * -1.4426950408889634f;
                            __builtin_amdgcn_sched_barrier(0);
#pragma unroll
                            for (int j = 0; j < 8; ++j) h[j] = __builtin_amdgcn_exp2f(h[j]);
                            __builtin_amdgcn_sched_barrier(0);
#pragma unroll
                            for (int j = 0; j < 8; ++j) h[j] = h[j] + 1.0f;
                            __builtin_amdgcn_sched_barrier(0);
#pragma unroll
                            for (int j = 0; j < 8; ++j) h[j] = __builtin_amdgcn_rcpf(h[j]);
                            __builtin_amdgcn_sched_barrier(0);
                        }
                        u32x4 w; w.x = cvt_pk_bf16(h[0], h[1]); w.y = cvt_pk_bf16(h[2], h[3]); w.z = cvt_pk_bf16(h[4], h[5]); w.w = cvt_pk_bf16(h[6], h[7]);
                        const int c = bj * HALF + cw;
                        if (pn < 2) {
                            const int ch = pn * 256 + c, b = row >> 13, s = row & (S_ - 1), q = ch >> 2;
                            bf16_t* d0 = Uq + (((size_t)(b * 128 + q)) * S_ + s) * 4;
                            *(GAS u32x2*)d0 = (u32x2){w.x, w.y}; *(GAS u32x2*)(d0 + (size_t)S_ * 4) = (u32x2){w.z, w.w};
                        } else if (pn < 4) { *(GAS u32x4*)(Bv + (size_t)row * 512 + (pn - 2) * 256 + c) = w;
                        } else if (pn < 10) { *(GAS u32x4*)(Pu + (size_t)row * 512 + (pn - 8) * 256 + c) = w;
                        } else {
#pragma unroll
                            for (int j = 0; j < 8; ++j) h[j] = fmaxf(h[j] * 255.0f, 1.0f);
                            const u32x2 gq = (u32x2){pack_u8x4(h[0], h[1], h[2], h[3]), pack_u8x4(h[4], h[5], h[6], h[7])};
                            if (bj == 0) g0 = gq; else *(GAS u32x4*)((GAS unsigned char*)Gt + (size_t)row * 3072 + (pn - 10) * 256 + (wc * 4 + fq) * 16) = (u32x4){g0.x, g0.y, gq.x, gq.y}; }
                    }
                }
            }
    }
};
template <class Epi>
__device__ __forceinline__ void gemm_phase(LAS unsigned char* lds, const Gemm g, const StaticOrder& S, const Epi& E, int wid) {
    const int lane = fresh_lane(), tid = wid * 64 + lane, wr = wid >> 2, wc = wid & 3, fr = lane & 15, fq = lane >> 4;
    const int nt = g.K / BK;
    unsigned voffA[2], voffB[2];
#pragma unroll
    for (int i = 0; i < 2; ++i) { int R, C; stage_rc(tid * 16 + i * 8192, R, C); const int Rb = Epi::PERM ? ((R & ~31) + perm32(R & 31)) : R;
        voffA[i] = (unsigned)(R * g.lda + C) * 2u; voffB[i] = (unsigned)(Rb * g.ldb + C) * 2u; }
    const size_t kstep = (size_t)(BK * 2);
    const size_t hstepA = (size_t)HALF * g.lda * 2, hstepB = (size_t)HALF * g.ldb * 2;
    const size_t tstepA = 2 * hstepA, tstepB = 2 * hstepB;
    const unsigned ldsw = (unsigned)wid * 1024u;
    const int aoff = lds_byte(wr * 64 + fr, fq * 8), boff = lds_byte(wc * 32 + fr, fq * 8);
#define G_SA(b, h) (((b) * 2 + (h)) * HTB)
#define G_SB(b, h) ((4 + (b) * 2 + (h)) * HTB)
#define G_STAGE(bufoff, gbase, voff) do { _Pragma("unroll") for (int _i = 0; _i < 2; ++_i) \
        __builtin_amdgcn_global_load_lds((const unsigned*)((const char*)(gbase) + (voff)[_i]), (LAS unsigned*)(lds + (bufoff) + ldsw + _i * 8192), 16, 0, 0); } while (0)
#define G_LDA(dst, b, h) do { _Pragma("unroll") for (int m = 0; m < 4; ++m) _Pragma("unroll") for (int k = 0; k < 2; ++k) dst[m][k] = *(const LAS bf16x8*)(lds + G_SA(b, h) + aoff + m * 2048 + k * 1024); } while (0)
#define G_LDB(dst, b, h) do { _Pragma("unroll") for (int n = 0; n < 2; ++n) _Pragma("unroll") for (int k = 0; k < 2; ++k) dst[n][k] = *(const LAS bf16x8*)(lds + G_SB(b, h) + boff + n * 2048 + k * 1024); } while (0)
#define G_MMA(ai, bj, At, Bt) do { __builtin_amdgcn_s_setprio(1); _Pragma("unroll") for (int m = 0; m < 4; ++m) _Pragma("unroll") for (int n = 0; n < 2; ++n) _Pragma("unroll") for (int k = 0; k < 2; ++k) \
        acc[ai][bj][m][n] = __builtin_amdgcn_mfma_f32_16x16x32_bf16(Bt[n][k], At[m][k], acc[ai][bj][m][n], 0, 0, 0); __builtin_amdgcn_s_setprio(0); } while (0)
#define G_WAIT_V(n) asm volatile("s_waitcnt vmcnt(" #n ")" ::: "memory")
#define G_WAIT_L(n) asm volatile("s_waitcnt lgkmcnt(" #n ")" ::: "memory")
#define G_BAR __builtin_amdgcn_s_barrier()
#define G_SCHED __builtin_amdgcn_sched_barrier(0)
    Unit cur, nxt; int ui = 0;
    if (!S.next(0, cur)) return;
    Acc acc;
#pragma unroll
    for (int a = 0; a < 2; ++a)
#pragma unroll
        for (int b = 0; b < 2; ++b)
#pragma unroll
            for (int m = 0; m < 4; ++m)
#pragma unroll
                for (int n = 0; n < 2; ++n) acc[a][b][m][n] = (f32x4){0.f, 0.f, 0.f, 0.f};
    bf16x8 At[4][2], B0[2][2], B1[2][2];
    const char* cA = (const char*)g.A + (size_t)cur.pm * tstepA + (size_t)cur.pn * g.acs; const char* cB = (const char*)g.Bt + (size_t)cur.pn * tstepB;
    G_STAGE(G_SB(0, 0), cB, voffB); G_STAGE(G_SA(0, 0), cA, voffA); G_STAGE(G_SB(0, 1), cB + hstepB, voffB); G_STAGE(G_SA(0, 1), cA + hstepA, voffA);
    if (wr == 1) G_BAR;
    G_WAIT_V(4); G_BAR;
    G_STAGE(G_SB(1, 0), cB + kstep, voffB); G_STAGE(G_SA(1, 0), cA + kstep, voffA); G_STAGE(G_SB(1, 1), cB + hstepB + kstep, voffB);
    G_WAIT_V(6); G_BAR;
    for (;;) {
        const bool has_next = S.next(ui + 1, nxt);
        const char* nA = has_next ? (const char*)g.A + (size_t)nxt.pm * tstepA + (size_t)nxt.pn * g.acs : cA; const char* nB = has_next ? (const char*)g.Bt + (size_t)nxt.pn * tstepB : cB;
        for (int t = 0; t < nt; t += 2) {
            const bool last = (t == nt - 2);
            const char* a1 = cA + (size_t)(t + 1) * kstep;
            const char* a2 = last ? nA : cA + (size_t)(t + 2) * kstep; const char* b2 = last ? nB : cB + (size_t)(t + 2) * kstep;
            const char* a3 = a2 + kstep; const char* b3 = b2 + kstep;
            if constexpr (Epi::PREFETCH) { if (last) {
                __builtin_amdgcn_global_load_lds((const unsigned*)((const char*)E.r + ((size_t)cur.pm * BM + (wid & 3) * 64 + lane) * 16), (LAS unsigned*)(lds + LDS_RS + (wid & 3) * 1024), 16, 0, 0); } }
            G_LDB(B0, 0, 0); G_SCHED; G_LDA(At, 0, 0); G_STAGE(G_SA(1, 1), a1 + hstepA, voffA);
            G_WAIT_L(8); G_BAR; G_WAIT_L(0); G_MMA(0, 0, At, B0); G_BAR; G_SCHED;
            G_LDB(B1, 0, 1); G_STAGE(G_SB(0, 0), b2, voffB);
            G_BAR; G_WAIT_L(0); G_MMA(0, 1, At, B1); G_BAR;
            G_LDA(At, 0, 1); G_STAGE(G_SA(0, 0), a2, voffA);
            G_BAR; G_WAIT_L(0); G_MMA(1, 0, At, B0); G_BAR; G_SCHED;
            G_STAGE(G_SB(0, 1), b2 + hstepB, voffB);
            G_WAIT_V(6); G_BAR; G_MMA(1, 1, At, B1); G_BAR;
            G_LDB(B0, 1, 0); G_SCHED; G_LDA(At, 1, 0); G_STAGE(G_SA(0, 1), a2 + hstepA, voffA);
            G_WAIT_L(8); G_BAR; G_WAIT_L(0); G_MMA(0, 0, At, B0); G_BAR; G_SCHED;
            G_LDB(B1, 1, 1); G_STAGE(G_SB(1, 0), b3, voffB);
            G_BAR; G_WAIT_L(0); G_MMA(0, 1, At, B1); G_BAR;
            G_LDA(At, 1, 1); G_STAGE(G_SA(1, 0), a3, voffA);
            G_BAR; G_WAIT_L(0); G_MMA(1, 0, At, B0); G_BAR; G_SCHED;
            G_STAGE(G_SB(1, 1), b3 + hstepB, voffB);
            G_WAIT_V(6); G_BAR; G_MMA(1, 1, At, B1); G_BAR;
        }
        { const int l2 = fresh_lane(); E(acc, cur, wr, wc, l2 & 15, l2 >> 4); }
        if (!has_next) break;
#pragma unroll
        for (int a = 0; a < 2; ++a)
#pragma unroll
            for (int b = 0; b < 2; ++b)
#pragma unroll
                for (int m = 0; m < 4; ++m)
#pragma unroll
                    for (int n = 0; n < 2; ++n) acc[a][b][m][n] = (f32x4){0.f, 0.f, 0.f, 0.f};
        cur = nxt; cA = nA; cB = nB; ++ui;
    }
    G_WAIT_V(0);
    if (wr == 0) G_BAR;
    G_BAR;
}

struct MergeOps {
    const bf16_t *PQ, *PC, *WFp;
    __device__ __forceinline__ bool next(const StaticOrder& S, int i, Unit& u) const { const int ti = i / 3; if (!S.next(ti, u)) return false; u.seg = i - ti * 3; return true; }
    __device__ __forceinline__ int nt(const Unit& u) const { return u.seg == 0 ? 4 : (u.seg == 1 ? 2 : 8); }
    __device__ __forceinline__ const char* opA(const Unit& u) const {
        if (u.seg == 0) return (const char*)(PQ + ((size_t)(((u.pm >> 5) * 128 + u.pn * 32)) * S_ + (size_t)(u.pm & 31) * BM) * 8);
        return (const char*)(PC + (size_t)u.pm * BM * 1024 + (u.seg == 1 ? u.pn * 128 : 512)); }
    __device__ __forceinline__ void aparams(const Unit& u, int tid, unsigned& v0, unsigned& v1, unsigned& hstep, unsigned& kstep) const {
        int R0, C0, R1, C1; stage_rc(tid * 16, R0, C0); stage_rc(tid * 16 + 8192, R1, C1);
        if (u.seg == 0) { v0 = (unsigned)(C0 >> 3) * (unsigned)(S_ * 16) + (unsigned)R0 * 16u; v1 = (unsigned)(C1 >> 3) * (unsigned)(S_ * 16) + (unsigned)R1 * 16u; hstep = HALF * 16; kstep = 8u * S_ * 16u; }
        else { v0 = (unsigned)(R0 * 1024 + C0) * 2u; v1 = (unsigned)(R1 * 1024 + C1) * 2u; hstep = HALF * 1024 * 2; kstep = BK * 2; } }
    __device__ __forceinline__ const char* opB(const Unit& u) const {
        return (const char*)(WFp + (size_t)u.seg * 1024 * 512 + (size_t)u.pn * BM * 512); }
};
struct EpiMergeSeg {
    static constexpr bool PERM = true, PREFETCH = false;
    bf16_t* Mg; const bf16_t* Gt;
    __device__ __forceinline__ void run(Acc& acc, const Unit& u, int wr, int wc, int fr, int fq) const {
        const int seg = u.seg; const bool fin = seg == 2;
        const int noff = seg == 0 ? 0 : (seg == 1 ? 2048 : 1024), doff = seg == 0 ? 2048 : 1024;
        const int row0 = u.pm * BM + wr * 64 + fr, col0 = u.pn * BM + wc * 32 + 8 * fq, gcol = u.pn * BM + (wc * 4 + fq) * 16;
        const GAS unsigned char* nb = (const GAS unsigned char*)Gt + (size_t)row0 * 3072 + gcol + noff;
        const GAS unsigned char* db = (const GAS unsigned char*)Gt + (size_t)row0 * 3072 + gcol + doff;
        GAS bf16_t* mb = (GAS bf16_t*)Mg + (size_t)row0 * D_ + col0;
        u32x4 nv[8], dv[8];
#define MS_LOAD(s) do { nv[(s)] = *(const GAS u32x4*)(nb); if (!fin) dv[(s)] = *(const GAS u32x4*)(db); \
        nb += (((s) & 3) == 3 ? (HALF - 48) : 16) * 3072; db += (((s) & 3) == 3 ? (HALF - 48) : 16) * 3072; } while (0)
        MS_LOAD(0); MS_LOAD(1); MS_LOAD(2); MS_LOAD(3); MS_LOAD(4); MS_LOAD(5); MS_LOAD(6); MS_LOAD(7);
#pragma unroll
        for (int st = 0; st < 8; ++st) {
            const int ai = st >> 2, m = st & 3;
#pragma unroll
            for (int bj = 0; bj < 2; ++bj) {
                const u32x2 n_ = bj ? (u32x2){nv[st].z, nv[st].w} : (u32x2){nv[st].x, nv[st].y}, d_ = bj ? (u32x2){dv[st].z, dv[st].w} : (u32x2){dv[st].x, dv[st].y};
                float rn[8] = {ubf(n_.x, 0), ubf(n_.x, 1), ubf(n_.x, 2), ubf(n_.x, 3),
                               ubf(n_.y, 0), ubf(n_.y, 1), ubf(n_.y, 2), ubf(n_.y, 3)};
                float rd[8];
                if (fin) {
#pragma unroll
                    for (int j = 0; j < 8; ++j) rd[j] = 1.0f / 255.0f;
                } else {
                    rd[0] = ubf(d_.x, 0); rd[1] = ubf(d_.x, 1); rd[2] = ubf(d_.x, 2); rd[3] = ubf(d_.x, 3);
                    rd[4] = ubf(d_.y, 0); rd[5] = ubf(d_.y, 1); rd[6] = ubf(d_.y, 2); rd[7] = ubf(d_.y, 3);
#pragma unroll
                    for (int j = 0; j < 8; ++j) rd[j] = __builtin_amdgcn_rcpf(fmaxf(rd[j], 1.0f));
                }
#pragma unroll
                for (int j = 0; j < 8; ++j) acc[ai][bj][m][j >> 2][j & 3] *= rn[j] * rd[j];
                if (fin) { const f32x4 a0 = acc[ai][bj][m][0], a1 = acc[ai][bj][m][1];
                    u32x4 w; w.x = cvt_pk_bf16(a0.x, a0.y); w.y = cvt_pk_bf16(a0.z, a0.w); w.z = cvt_pk_bf16(a1.x, a1.y); w.w = cvt_pk_bf16(a1.z, a1.w);
                    *(GAS u32x4*)(mb + bj * HALF) = w; }
            }
            mb += ((st & 3) == 3 ? (HALF - 48) : 16) * D_;
        }
#undef MS_LOAD
    }
};
template <class Epi>
__device__ __forceinline__ void gemm_merge_phase(LAS unsigned char* lds, const MergeOps g, const StaticOrder& S, const Epi& E, int wid) {
    const int lane = fresh_lane(), tid = wid * 64 + lane, wr = wid >> 2, wc = wid & 3, fr = lane & 15, fq = lane >> 4;
    unsigned voffB[2];
#pragma unroll
    for (int i = 0; i < 2; ++i) { int R, C; stage_rc(tid * 16 + i * 8192, R, C); const int Rb = Epi::PERM ? ((R & ~31) + perm32(R & 31)) : R;
        voffB[i] = (unsigned)(Rb * 512 + C) * 2u; }
    const size_t kstep = (size_t)(BK * 2);
    const size_t hstepB = (size_t)HALF * 512 * 2;
    const unsigned ldsw = (unsigned)wid * 1024u;
    const int aoff = lds_byte(wr * 64 + fr, fq * 8), boff = lds_byte(wc * 32 + fr, fq * 8);
#define G_SA(b, h) (((b) * 2 + (h)) * HTB)
#define G_SB(b, h) ((4 + (b) * 2 + (h)) * HTB)
#define G_STAGE(bufoff, gbase, voff) do { _Pragma("unroll") for (int _i = 0; _i < 2; ++_i) \
        __builtin_amdgcn_global_load_lds((const unsigned*)((const char*)(gbase) + (voff)[_i]), (LAS unsigned*)(lds + (bufoff) + ldsw + _i * 8192), 16, 0, 0); } while (0)
#define G_STAGE_A(bufoff, gbase, v0_, v1_) do { \
        __builtin_amdgcn_global_load_lds((const unsigned*)((const char*)(gbase) + (v0_)), (LAS unsigned*)(lds + (bufoff) + ldsw), 16, 0, 0); \
        __builtin_amdgcn_global_load_lds((const unsigned*)((const char*)(gbase) + (v1_)), (LAS unsigned*)(lds + (bufoff) + ldsw + 8192), 16, 0, 0); } while (0)
#define G_LDA(dst, b, h) do { _Pragma("unroll") for (int m = 0; m < 4; ++m) _Pragma("unroll") for (int k = 0; k < 2; ++k) dst[m][k] = *(const LAS bf16x8*)(lds + G_SA(b, h) + aoff + m * 2048 + k * 1024); } while (0)
#define G_LDB(dst, b, h) do { _Pragma("unroll") for (int n = 0; n < 2; ++n) _Pragma("unroll") for (int k = 0; k < 2; ++k) dst[n][k] = *(const LAS bf16x8*)(lds + G_SB(b, h) + boff + n * 2048 + k * 1024); } while (0)
#define G_MMA(ai, bj, At, Bt) do { __builtin_amdgcn_s_setprio(1); _Pragma("unroll") for (int m = 0; m < 4; ++m) _Pragma("unroll") for (int n = 0; n < 2; ++n) _Pragma("unroll") for (int k = 0; k < 2; ++k) \
        acc[ai][bj][m][n] = __builtin_amdgcn_mfma_f32_16x16x32_bf16(Bt[n][k], At[m][k], acc[ai][bj][m][n], 0, 0, 0); __builtin_amdgcn_s_setprio(0); } while (0)
#define G_WAIT_V(n) asm volatile("s_waitcnt vmcnt(" #n ")" ::: "memory")
#define G_WAIT_L(n) asm volatile("s_waitcnt lgkmcnt(" #n ")" ::: "memory")
#define G_BAR __builtin_amdgcn_s_barrier()
#define G_SCHED __builtin_amdgcn_sched_barrier(0)
    Unit cur, nxt; int ui = 0;
    if (!g.next(S, 0, cur)) return;
    int nt = g.nt(cur);
    unsigned vc0, vc1, hc, kc, vn0, vn1, hn, kn;
    g.aparams(cur, tid, vc0, vc1, hc, kc);
    Acc acc;
#pragma unroll
    for (int a = 0; a < 2; ++a)
#pragma unroll
        for (int b = 0; b < 2; ++b)
#pragma unroll
            for (int m = 0; m < 4; ++m)
#pragma unroll
                for (int n = 0; n < 2; ++n) acc[a][b][m][n] = (f32x4){0.f, 0.f, 0.f, 0.f};
    bf16x8 At[4][2], B0[2][2], B1[2][2];
    const char* cA = g.opA(cur); const char* cB = g.opB(cur);
    G_STAGE(G_SB(0, 0), cB, voffB); G_STAGE_A(G_SA(0, 0), cA, vc0, vc1); G_STAGE(G_SB(0, 1), cB + hstepB, voffB); G_STAGE_A(G_SA(0, 1), cA + hc, vc0, vc1);
    if (wr == 1) G_BAR;
    G_WAIT_V(4); G_BAR;
    G_STAGE(G_SB(1, 0), cB + kstep, voffB); G_STAGE_A(G_SA(1, 0), cA + kc, vc0, vc1); G_STAGE(G_SB(1, 1), cB + hstepB + kstep, voffB);
    G_WAIT_V(6); G_BAR;
    for (;;) {
        const bool has_next = g.next(S, ui + 1, nxt);
        const char* nA = has_next ? g.opA(nxt) : cA; const char* nB = has_next ? g.opB(nxt) : cB;
        if (has_next) g.aparams(nxt, tid, vn0, vn1, hn, kn); else { vn0 = vc0; vn1 = vc1; hn = hc; kn = kc; }
        for (int t = 0; t < nt; t += 2) {
            const bool last = (t == nt - 2);
            const char* a1 = cA + (size_t)(t + 1) * kc;
            const char* a2 = last ? nA : cA + (size_t)(t + 2) * kc; const char* b2 = last ? nB : cB + (size_t)(t + 2) * kstep;
            const unsigned w0 = last ? vn0 : vc0, w1 = last ? vn1 : vc1, h2 = last ? hn : hc, k2 = last ? kn : kc;
            const char* a3 = a2 + k2; const char* b3 = b2 + kstep;
            if constexpr (Epi::PREFETCH) { if (last) {
                __builtin_amdgcn_global_load_lds((const unsigned*)((const char*)E.r + ((size_t)cur.pm * BM + (wid & 3) * 64 + lane) * 16), (LAS unsigned*)(lds + LDS_RS + (wid & 3) * 1024), 16, 0, 0); } }
            G_LDB(B0, 0, 0); G_SCHED; G_LDA(At, 0, 0); G_STAGE_A(G_SA(1, 1), a1 + hc, vc0, vc1);
            G_WAIT_L(8); G_BAR; G_WAIT_L(0); G_MMA(0, 0, At, B0); G_BAR; G_SCHED;
            G_LDB(B1, 0, 1); G_STAGE(G_SB(0, 0), b2, voffB);
            G_BAR; G_WAIT_L(0); G_MMA(0, 1, At, B1); G_BAR;
            G_LDA(At, 0, 1); G_STAGE_A(G_SA(0, 0), a2, w0, w1);
            G_BAR; G_WAIT_L(0); G_MMA(1, 0, At, B0); G_BAR; G_SCHED;
            G_STAGE(G_SB(0, 1), b2 + hstepB, voffB);
            G_WAIT_V(6); G_BAR; G_MMA(1, 1, At, B1); G_BAR;
            G_LDB(B0, 1, 0); G_SCHED; G_LDA(At, 1, 0); G_STAGE_A(G_SA(0, 1), a2 + h2, w0, w1);
            G_WAIT_L(8); G_BAR; G_WAIT_L(0); G_MMA(0, 0, At, B0); G_BAR; G_SCHED;
            G_LDB(B1, 1, 1); G_STAGE(G_SB(1, 0), b3, voffB);
            G_BAR; G_WAIT_L(0); G_MMA(0, 1, At, B1); G_BAR;
            G_LDA(At, 1, 1); G_STAGE_A(G_SA(1, 0), a3, w0, w1);
            G_BAR; G_WAIT_L(0); G_MMA(1, 0, At, B0); G_BAR; G_SCHED;
            G_STAGE(G_SB(1, 1), b3 + hstepB, voffB);
            G_WAIT_V(6); G_BAR; G_MMA(1, 1, At, B1); G_BAR;
        }
        { const int l2 = fresh_lane(); E.run(acc, cur, wr, wc, l2 & 15, l2 >> 4); }
        if (!has_next) break;
        if (cur.seg == 2) {
#pragma unroll
            for (int a = 0; a < 2; ++a)
#pragma unroll
                for (int b = 0; b < 2; ++b)
#pragma unroll
                    for (int m = 0; m < 4; ++m)
#pragma unroll
                        for (int n = 0; n < 2; ++n) acc[a][b][m][n] = (f32x4){0.f, 0.f, 0.f, 0.f};
        }
        cur = nxt; cA = nA; cB = nB; ++ui; nt = g.nt(cur); vc0 = vn0; vc1 = vn1; hc = hn; kc = kn;
    }
    G_WAIT_V(0);
    if (wr == 0) G_BAR;
    G_BAR;
}


#define FFT_FN __device__ __forceinline__
struct c2 { float x, y; };
FFT_FN c2 c_add(c2 a, c2 b) { return c2{a.x + b.x, a.y + b.y}; }
FFT_FN c2 c_sub(c2 a, c2 b) { return c2{a.x - b.x, a.y - b.y}; }
FFT_FN c2 c_mul(c2 a, c2 b) { return c2{a.x * b.x - a.y * b.y, a.x * b.y + a.y * b.x}; }
template <class PX, class PT> FFT_FN void fft_r4_stage(PX X, int tid, int lq, PT tw) {
    const int q = 1 << lq, tws = 13 - (lq + 2);
#pragma unroll 1
    for (int ob = 0; ob < 2; ++ob)
#pragma unroll
    for (int ii = 0; ii < 4; ++ii) { const int it = ob * 4 + ii;
        const int idx = tid + 512 * it, seq = idx >> 11, i = idx & 2047, blk = i >> lq, j = i & (q - 1), p = seq * 8192 + (blk << (lq + 2)) + j;
        const c2 a0 = X[p], a1 = X[p + q], a2 = X[p + 2 * q], a3 = X[p + 3 * q];
        const c2 t0 = c_add(a0, a2), t1 = c_sub(a0, a2), t2 = c_add(a1, a3), d = c_sub(a1, a3), t3 = c2{d.y, -d.x};
        const c2 y0 = c_add(t0, t2), y1 = c_add(t1, t3), y2 = c_sub(t0, t2), y3 = c_sub(t1, t3);
        const int tj = j << tws;
        X[p] = y0; X[p + q] = c_mul(y1, tw[tj]); X[p + 2 * q] = c_mul(y2, tw[2 * tj]); X[p + 3 * q] = c_mul(y3, tw[3 * tj]);
    }
}
template <class PX> FFT_FN void fft_r2_last(PX X, int tid) {
    for (int it = 0; it < 16; ++it) { const int p = 2 * (tid + 512 * it); const c2 a = X[p], b = X[p + 1]; X[p] = c_add(a, b); X[p + 1] = c_sub(a, b); }
}
FFT_FN int fft_pos(int k) {
    int pos = 0;
    for (int s = 0; s < 6; ++s) { pos += (k & 3) << (11 - 2 * s); k >>= 2; }
    return pos + (k & 1);
}

struct TwHw {
    __device__ __forceinline__ c2 operator[](int k) const { const float x = (float)k * (1.0f / 8192.0f); return c2{__builtin_amdgcn_cosf(x), -__builtin_amdgcn_sinf(x)}; }
};
__device__ __forceinline__ void pool_issue(const GAS bf16_t* Pu, int tok0, int c8, int hf, u32x4 (&w)[24]) {
    const int s0 = tok0 & (S_ - 1);
    const GAS bf16_t* base = Pu + (size_t)(tok0 - s0) * 512 + c8 * 8;
#pragma unroll
    for (int i = 0; i < 24; ++i) { const int sidx = s0 - 8 + i; w[i] = (u32x4){0u, 0u, 0u, 0u}; if (i >= 8 - hf && i < 16 + hf && sidx >= 0 && sidx < S_) w[i] = *(const GAS u32x4*)(base + (size_t)sidx * 512); }
}
template <int HF> __device__ __forceinline__ void pool_consume(GAS bf16_t* Pl, int tok0, int c8, const u32x4 (&w)[24]) {
    const int s0 = tok0 & (S_ - 1);
    float a[8];
#pragma unroll
    for (int j = 0; j < 8; ++j) a[j] = 0.f;
#pragma unroll
    for (int i = 8 - HF; i < 8 + HF; ++i) { a[0] += bf_lo(w[i].x); a[1] += bf_hi(w[i].x); a[2] += bf_lo(w[i].y); a[3] += bf_hi(w[i].y); a[4] += bf_lo(w[i].z); a[5] += bf_hi(w[i].z); a[6] += bf_lo(w[i].w); a[7] += bf_hi(w[i].w); }
    GAS bf16_t* dst = Pl + (size_t)tok0 * 1024 + c8 * 8;
#pragma unroll
    for (int j = 0; j < 8; ++j) {
        const int t = s0 + j; const int lo = t - HF < 0 ? 0 : t - HF, hi = t + HF > S_ ? S_ : t + HF; const float ic = 1.0f / (float)(hi - lo);
        const u32x4 u = w[8 + j];
        u32x4 o; o.x = cvt_pk_bf16(a[0] * ic - bf_lo(u.x), a[1] * ic - bf_hi(u.x)); o.y = cvt_pk_bf16(a[2] * ic - bf_lo(u.y), a[3] * ic - bf_hi(u.y));
        o.z = cvt_pk_bf16(a[4] * ic - bf_lo(u.z), a[5] * ic - bf_hi(u.z)); o.w = cvt_pk_bf16(a[6] * ic - bf_lo(u.w), a[7] * ic - bf_hi(u.w));
        *(GAS u32x4*)(dst + (size_t)j * 1024) = o;
        if (j < 7) { const u32x4 p = w[8 + HF + j], q = w[8 - HF + j];
            a[0] += bf_lo(p.x) - bf_lo(q.x); a[1] += bf_hi(p.x) - bf_hi(q.x); a[2] += bf_lo(p.y) - bf_lo(q.y); a[3] += bf_hi(p.y) - bf_hi(q.y);
            a[4] += bf_lo(p.z) - bf_lo(q.z); a[5] += bf_hi(p.z) - bf_hi(q.z); a[6] += bf_lo(p.w) - bf_lo(q.w); a[7] += bf_hi(p.w) - bf_hi(q.w); }
    }
}
__device__ __forceinline__ void pool_consume_any(GAS bf16_t* Pl, int tok0, int c8, int grp, const u32x4 (&w)[24]) {
    if (grp == 0) pool_consume<1>(Pl, tok0, c8, w); else if (grp == 1) pool_consume<2>(Pl, tok0, c8, w); else if (grp == 2) pool_consume<4>(Pl, tok0, c8, w); else pool_consume<8>(Pl, tok0, c8, w);
}
__device__ __forceinline__ void conv_issue(const GAS bf16_t* Z, const GAS bf16_t* Bv, const GAS float* wc, int tok0, int lane, u32x4 (&z)[10], u32x4 (&bb)[8], f32x4 (&wt)[6]) {
    const int s0 = tok0 & (S_ - 1);
    const GAS bf16_t* zp = Z + (size_t)tok0 * 512 + lane * 8; const GAS bf16_t* bp = Bv + (size_t)tok0 * 512 + lane * 8;
#pragma unroll
    for (int i = 0; i < 10; ++i) { const int sidx = s0 - 1 + i; z[i] = (u32x4){0u, 0u, 0u, 0u}; if (sidx >= 0 && sidx < S_) z[i] = *(const GAS u32x4*)(zp + (ptrdiff_t)(i - 1) * 512); }
#pragma unroll
    for (int j = 0; j < 8; ++j) bb[j] = *(const GAS u32x4*)(bp + (size_t)j * 512);
    wt[0] = *(const GAS f32x4*)(wc); wt[1] = *(const GAS f32x4*)(wc + 4); wt[2] = *(const GAS f32x4*)(wc + 512); wt[3] = *(const GAS f32x4*)(wc + 516); wt[4] = *(const GAS f32x4*)(wc + 1024); wt[5] = *(const GAS f32x4*)(wc + 1028);
}
__device__ __forceinline__ void conv_consume(GAS bf16_t* Bc, int tok0, int lane, const u32x4 (&z)[10], const u32x4 (&bb)[8], const f32x4 (&wt)[6]) {
    const f32x4 w0a = wt[0], w0b = wt[1], w1a = wt[2], w1b = wt[3], w2a = wt[4], w2b = wt[5];
    GAS bf16_t* op = Bc + (size_t)tok0 * 1024 + lane * 8;
#pragma unroll
    for (int j = 0; j < 8; ++j) { const u32x4 zm = z[j], zz = z[j + 1], zq = z[j + 2], b_ = bb[j];
        float h[8];
        h[0] = bf_lo(b_.x) * (w0a.x * bf_lo(zm.x) + w1a.x * bf_lo(zz.x) + w2a.x * bf_lo(zq.x));
        h[1] = bf_hi(b_.x) * (w0a.y * bf_hi(zm.x) + w1a.y * bf_hi(zz.x) + w2a.y * bf_hi(zq.x));
        h[2] = bf_lo(b_.y) * (w0a.z * bf_lo(zm.y) + w1a.z * bf_lo(zz.y) + w2a.z * bf_lo(zq.y));
        h[3] = bf_hi(b_.y) * (w0a.w * bf_hi(zm.y) + w1a.w * bf_hi(zz.y) + w2a.w * bf_hi(zq.y));
        h[4] = bf_lo(b_.z) * (w0b.x * bf_lo(zm.z) + w1b.x * bf_lo(zz.z) + w2b.x * bf_lo(zq.z));
        h[5] = bf_hi(b_.z) * (w0b.y * bf_hi(zm.z) + w1b.y * bf_hi(zz.z) + w2b.y * bf_hi(zq.z));
        h[6] = bf_lo(b_.w) * (w0b.z * bf_lo(zm.w) + w1b.z * bf_lo(zz.w) + w2b.z * bf_lo(zq.w));
        h[7] = bf_hi(b_.w) * (w0b.w * bf_hi(zm.w) + w1b.w * bf_hi(zz.w) + w2b.w * bf_hi(zq.w));
        u32x4 o; o.x = cvt_pk_bf16(h[0], h[1]); o.y = cvt_pk_bf16(h[2], h[3]); o.z = cvt_pk_bf16(h[4], h[5]); o.w = cvt_pk_bf16(h[6], h[7]);
        *(GAS u32x4*)(op + (size_t)j * 1024) = o; }
}
__device__ __forceinline__ int rowmap(int mode, int n) {
    if (mode == 0) return n;
    if (mode == 1) return ((n >> 7) << 8) + (n & 127);
    if (mode == 2) return ((n >> 7) << 8) + 128 + (n & 127);
    if (n < 1024 || n >= 2048) return n;
    if (n < 1536) { const int i = n - 1024; return 1024 + ((i >> 7) << 8) + (i & 127); }
    { const int i = n - 1536; return 1024 + ((i >> 7) << 8) + 128 + (i & 127); }
}
__device__ __forceinline__ void tr_item(const float* W_, int N, bf16_t* WT_, int ldt, const float* kgain_, const float* nscale_, int mode, int row_off, float* scr_, int item, int lane) {
    const GAS float* W = (const GAS float*)W_; GAS bf16_t* WT = (GAS bf16_t*)WT_; const GAS float* kgain = (const GAS float*)kgain_; const GAS float* nscale = (const GAS float*)nscale_;
    LAS float* scr = (LAS float*)scr_;
    const int nblk = N >> 5, kb = item / nblk, nb = item - kb * nblk, k0 = kb << 6, n0 = nb << 5;
    const int kr = lane >> 3, n4 = (lane & 7) * 4;
    f32x4 v[8]; float kg[8];
#pragma unroll
    for (int i = 0; i < 8; ++i) { v[i] = *(const GAS f32x4*)(W + (size_t)(k0 + kr + 8 * i) * N + n0 + n4); kg[i] = kgain_ ? kgain[k0 + kr + 8 * i] : 1.0f; }
#pragma unroll
    for (int i = 0; i < 8; ++i) { LAS float* d = scr + (kr + 8 * i) * 33 + n4; d[0] = v[i].x * kg[i]; d[1] = v[i].y * kg[i]; d[2] = v[i].z * kg[i]; d[3] = v[i].w * kg[i]; }
    asm volatile("s_waitcnt lgkmcnt(0)" ::: "memory");
    const int c = lane & 7;
#pragma unroll
    for (int j = 0; j < 4; ++j) { const int n = (lane >> 3) + 8 * j; const LAS float* sp = scr + (8 * c) * 33 + n; const float ns = nscale_ ? nscale[n0 + n] : 1.0f;
        u32x4 o; o.x = cvt_pk_bf16(sp[0 * 33] * ns, sp[1 * 33] * ns); o.y = cvt_pk_bf16(sp[2 * 33] * ns, sp[3 * 33] * ns); o.z = cvt_pk_bf16(sp[4 * 33] * ns, sp[5 * 33] * ns); o.w = cvt_pk_bf16(sp[6 * 33] * ns, sp[7 * 33] * ns);
        *(GAS u32x4*)(WT + (size_t)(row_off + rowmap(mode, n0 + n)) * ldt + k0 + 8 * c) = o; }
    asm volatile("s_waitcnt lgkmcnt(0)" ::: "memory");
}

__device__ __forceinline__ void phase_prep(const Params& p, unsigned char* ws, int bid, int nblk, int wid, int l, unsigned char* shm) {
    const int lane = fresh_lane(), wave = wid, tid = wid * 64 + lane;
    float* scr = (float*)shm + wave * (64 * 33);
    const int gw = bid * 8 + wave, NGW = nblk * 8;
    constexpr int I_FF = 16 * 88, I_IN = 16 * 176, I_CO = 8 * 32, I_O = 16 * 32, I_P = 2 * 8;
    constexpr int NITEMS = 6 * I_FF + I_IN + I_CO + I_O + 4 * I_P;
    const size_t oFF = (size_t)l * D_ * FF_;
    for (int it = gw; it < NITEMS; it += NGW) {
        int r = it;
        if (r < I_FF) { tr_item(inp(p, I_W1A) + oFF, FF_, (bf16_t*)(ws + W13A), D_, inp(p, I_GF1) + l * D_, nullptr, 1, 0, scr, r, lane); continue; } r -= I_FF;
        if (r < I_FF) { tr_item(inp(p, I_W3A) + oFF, FF_, (bf16_t*)(ws + W13A), D_, inp(p, I_GF1) + l * D_, nullptr, 2, 0, scr, r, lane); continue; } r -= I_FF;
        if (r < I_FF) { tr_item(inp(p, I_W2A) + oFF, D_, (bf16_t*)(ws + W2A), FF_, nullptr, nullptr, 0, 0, scr, r, lane); continue; } r -= I_FF;
        if (r < I_FF) { tr_item(inp(p, I_W1B) + oFF, FF_, (bf16_t*)(ws + W13B), D_, inp(p, I_GF2) + l * D_, nullptr, 1, 0, scr, r, lane); continue; } r -= I_FF;
        if (r < I_FF) { tr_item(inp(p, I_W3B) + oFF, FF_, (bf16_t*)(ws + W13B), D_, inp(p, I_GF2) + l * D_, nullptr, 2, 0, scr, r, lane); continue; } r -= I_FF;
        if (r < I_FF) { tr_item(inp(p, I_W2B) + oFF, D_, (bf16_t*)(ws + W2B), FF_, nullptr, nullptr, 0, 0, scr, r, lane); continue; } r -= I_FF;
        if (r < I_IN) { tr_item(inp(p, I_WIN) + (size_t)l * D_ * INW_, INW_, (bf16_t*)(ws + WIN), D_, inp(p, I_GMIX) + l * D_, nullptr, 3, 0, scr, r, lane); continue; } r -= I_IN;
        if (r < I_CO) { tr_item(inp(p, I_WCONVOUT) + (size_t)l * 512 * D_, D_, (bf16_t*)(ws + WCO), 512, nullptr, nullptr, 0, 0, scr, r, lane); continue; } r -= I_CO;
        if (r < I_O) { tr_item(inp(p, I_WO) + (size_t)l * D_ * D_, D_, (bf16_t*)(ws + WO), D_, nullptr, nullptr, 0, 0, scr, r, lane); continue; } r -= I_O;
        { const int g = r / I_P; r -= g * I_P;
          tr_item(inp(p, I_WPOOL) + ((size_t)l * 4 + g) * 128 * 256, 256, (bf16_t*)(ws + WP), 512, nullptr, inp(p, I_PSCALE) + l * D_ + g * 256, 0, g * 256, scr, r, lane); }
    }
    __syncthreads();
    float* ct = (float*)shm;
    if (tid < 128) ct[tid] = cospif((float)tid * (1.0f / 64.0f));
    __syncthreads();
    const float* wf = inp(p, I_WFOUR) + (size_t)l * 4 * 128 * 256;
    bf16_t* WFo = (bf16_t*)(ws + WF);
    for (int idx = bid * 512 + tid; idx < 4 * 256 * 256; idx += nblk * 512) {
        const int d = idx & 255, kc = (idx >> 8) & 255, g = idx >> 16, c = ((kc >> 3) << 2) + (kc & 3), isq = (kc >> 2) & 1, sh = isq ? 96 : 0;
        const float* w = wf + (size_t)g * 128 * 256 + d;
        float a = 0.f;
#pragma unroll 8
        for (int j = 0; j < 128; ++j) a += ct[(j * c + sh) & 127] * w[j * 256];
        if (isq) a = -a;
        WFo[(size_t)(g * 256 + d) * 512 + kc] = (bf16_t)(cvt_pk_bf16(a * (1.0f / 1024.0f), 0.f) & 0xffffu);
    }
    __syncthreads();
}

__device__ __forceinline__ void phase_norm(int bid, int nblk, int wid, const float* x, bf16_t* xb, float* r) {
    const int lane = fresh_lane(), gw = bid * 8 + wid, NGW = nblk * 8;
    for (int row = gw; row < T_; row += NGW) {
        const GAS f32x4* xr = (const GAS f32x4*)(x + (size_t)row * D_) + lane;
        f32x4 v[4]; float s = 0.f;
#pragma unroll
        for (int j = 0; j < 4; ++j) { v[j] = xr[64 * j]; s += (v[j].x * v[j].x + v[j].y * v[j].y) + (v[j].z * v[j].z + v[j].w * v[j].w); }
        s = wave_sum(s, lane);
        if (lane < 4) *(GAS float*)(r + (size_t)row * 4 + lane) = lane == 0 ? s : 0.f;
        GAS u32x2* o = (GAS u32x2*)(xb + (size_t)row * D_) + lane;
#pragma unroll
        for (int j = 0; j < 4; ++j) o[64 * j] = (u32x2){cvt_pk_bf16(v[j].x, v[j].y), cvt_pk_bf16(v[j].z, v[j].w)};
    }
}
__device__ __forceinline__ void phase_final(int bid, int nblk, int wid, const bf16_t* xb, float* out, const float* g, const float* ssp) {
    const int lane = fresh_lane(), gw = bid * 8 + wid, NGW = nblk * 8;
    for (int row = gw; row < T_; row += NGW) {
        const GAS u32x2* xr = (const GAS u32x2*)(xb + (size_t)row * D_) + lane;
        u32x2 v[4];
#pragma unroll
        for (int j = 0; j < 4; ++j) v[j] = xr[64 * j];
        const float rs = row_rs(ssp, row);
        GAS f32x4* o = (GAS f32x4*)(out + (size_t)row * D_) + lane;
#pragma unroll
        for (int j = 0; j < 4; ++j) { const f32x4 gg = ((const GAS f32x4*)g)[lane + 64 * j];
            o[64 * j] = (f32x4){bf_lo(v[j].x) * rs * gg.x, bf_hi(v[j].x) * rs * gg.y, bf_lo(v[j].y) * rs * gg.z, bf_hi(v[j].y) * rs * gg.w}; }
    }
}

__device__ __forceinline__ void phase_mix(const Params& p, unsigned char* ws, int bid, int nblk, int wid, int l, unsigned char* shm) {
    const int lane = fresh_lane(), tid0 = wid * 64 + lane;
    const GAS bf16_t* Uq = (const GAS bf16_t*)(ws + WS_P1);
    const GAS bf16_t* Bv = Uq + (size_t)T_ * 512; const GAS bf16_t* Z = Bv + (size_t)T_ * 512; const GAS bf16_t* Pu = Z + (size_t)T_ * 512;
    GAS bf16_t* PQ = (GAS bf16_t*)(ws + WS_XB);
    GAS bf16_t* Pl = (GAS bf16_t*)(ws + WS_P2); GAS bf16_t* Bc = Pl + 512;
    c2* X = (c2*)shm;
    TwHw tw;
    const int gw = bid * 8 + wid, NGW = nblk * 8;
    int ptask = gw, ctask = gw;
    int slot = 0;
    u32x4 v[8];
    if (bid < 512) { int tidp = tid0; asm volatile("" : "+v"(tidp)); const GAS u32x4* src0 = (const GAS u32x4*)(Uq + (size_t)bid * S_ * 4);
#pragma unroll
        for (int it = 0; it < 8; ++it) v[it] = src0[tidp + 512 * it]; }
    for (int item = bid; item < 512; item += nblk) {
        const int b = item >> 7, q = item & 127;
        int tidi = tid0; asm volatile("" : "+v"(tidi));
#pragma unroll
        for (int it = 0; it < 8; ++it) { const int i = tidi + 512 * it;
            X[2 * i] = c2{bf_lo(v[it].x), bf_hi(v[it].x)}; X[8192 + 2 * i] = c2{bf_lo(v[it].y), bf_hi(v[it].y)};
            X[2 * i + 1] = c2{bf_lo(v[it].z), bf_hi(v[it].z)}; X[8192 + 2 * i + 1] = c2{bf_lo(v[it].w), bf_hi(v[it].w)}; }
        __syncthreads();
#pragma unroll 1
        for (int sg = 0; sg < 7; ++sg, ++slot) {
            int tid = tid0; asm volatile("" : "+v"(tid));
            const bool do_pool = !(slot & 1) && ptask < 4096, do_conv = (slot & 1) && ctask < T_ / 8;
            if (do_pool) {
                const int grp = ptask & 3, chunk = (ptask >> 2) * 4 + (lane >> 4), c8 = grp * 16 + (lane & 15), tok0 = chunk * 8;
                u32x4 w[24]; pool_issue((const GAS bf16_t*)(ws + WS_P1) + (size_t)T_ * 1536, tok0, c8, 1 << grp, w);
                if (sg < 6) fft_r4_stage(X, tid, 11 - 2 * sg, tw); else fft_r2_last(X, tid);
                __syncthreads();
                pool_consume_any((GAS bf16_t*)(ws + WS_P2), tok0, c8, grp, w); ptask += NGW;
            } else if (do_conv) {
                const int tok0 = ctask * 8;
                u32x4 z[10], bb[8]; f32x4 wt[6];
                conv_issue((const GAS bf16_t*)(ws + WS_P1) + (size_t)T_ * 1024, (const GAS bf16_t*)(ws + WS_P1) + (size_t)T_ * 512, (const GAS float*)(inp(p, I_WCONV) + (size_t)l * 3 * 512) + lane * 8, tok0, lane, z, bb, wt);
                if (sg < 6) fft_r4_stage(X, tid, 11 - 2 * sg, tw); else fft_r2_last(X, tid);
                __syncthreads();
                conv_consume((GAS bf16_t*)(ws + WS_P2) + 512, tok0, lane, z, bb, wt); ctask += NGW;
            } else {
                if (sg < 6) fft_r4_stage(X, tid, 11 - 2 * sg, tw); else fft_r2_last(X, tid);
                __syncthreads();
            }
        }
        int tido = tid0; asm volatile("" : "+v"(tido));
        { const int nit = item + nblk < 512 ? item + nblk : item;
          const GAS u32x4* srcn = (const GAS u32x4*)(Uq + (size_t)nit * S_ * 4);
#pragma unroll
          for (int it = 0; it < 8; ++it) v[it] = srcn[tido + 512 * it]; }
        GAS bf16_t* dst = PQ + (size_t)item * S_ * 8;
#pragma unroll 4
        for (int it = 0; it < 16; ++it) { const int k = tido + 512 * it; const int p0 = fft_pos(k), p1 = fft_pos((S_ - k) & (S_ - 1));
            const c2 z0 = X[p0], w0 = X[p1], z1 = X[8192 + p0], w1 = X[8192 + p1];
            const float P0 = 0.5f * (z0.x + w0.x), Q0 = 0.5f * (w0.y - z0.y), P1 = 0.5f * (z0.y + w0.y), Q1 = 0.5f * (z0.x - w0.x);
            const float P2 = 0.5f * (z1.x + w1.x), Q2 = 0.5f * (w1.y - z1.y), P3 = 0.5f * (z1.y + w1.y), Q3 = 0.5f * (z1.x - w1.x);
            GAS bf16_t* d = dst + (size_t)k * 8;
            *(GAS u32x4*)d = (u32x4){cvt_pk_bf16(P0, P1), cvt_pk_bf16(P2, P3), cvt_pk_bf16(Q0, Q1), cvt_pk_bf16(Q2, Q3)}; }
        __syncthreads();
    }
    const int lane2 = fresh_lane();
    for (; ptask < 4096; ptask += NGW) {
        const int grp = ptask & 3, chunk = (ptask >> 2) * 4 + (lane2 >> 4), c8 = grp * 16 + (lane2 & 15), tok0 = chunk * 8;
        u32x4 w[24]; pool_issue(Pu, tok0, c8, 1 << grp, w); pool_consume_any(Pl, tok0, c8, grp, w);
    }
    for (; ctask < T_ / 8; ctask += NGW) {
        const int tok0 = ctask * 8;
        u32x4 z[10], bb[8]; f32x4 wt[6]; conv_issue(Z, Bv, (const GAS float*)(inp(p, I_WCONV) + (size_t)l * 3 * 512) + lane2 * 8, tok0, lane2, z, bb, wt); conv_consume(Bc, tok0, lane2, z, bb, wt);
    }
}

#define XB_TMO      128
#define XB_XCNT(j)  (256  + 64 * (j))
#define XB_XSUB(j)  (1280 + 64 * (j))
#define XB_XGEN(j)  (2304 + 64 * (j))
#define XB_TOP      3328
#define XB_TOPGEN   3392
#define XCD_BAR_WORDS 3456
#define XB_SPIN_CAP (1u << 18)
__device__ __forceinline__ unsigned xb_ld(unsigned* p)              { return __hip_atomic_load(p, __ATOMIC_RELAXED, __HIP_MEMORY_SCOPE_AGENT); }
__device__ __forceinline__ unsigned xb_add(unsigned* p, unsigned v) { return __hip_atomic_fetch_add(p, v, __ATOMIC_RELAXED, __HIP_MEMORY_SCOPE_AGENT); }
__device__ __forceinline__ unsigned xb_xcc_id() { return (unsigned)__builtin_amdgcn_s_getreg((3 << 11) | 20) & 0xFu; }
#define XB_SPIN(cond, bar) do { unsigned _sp = 0; while (cond) { __builtin_amdgcn_s_sleep(2); \
    if ((++_sp & 255u) == 0u) { if (xb_ld(&(bar)[XB_TMO])) break; if (_sp > XB_SPIN_CAP) { atomicAdd(&(bar)[XB_TMO], 1u); break; } } } } while (0)
__device__ __forceinline__ void xcd_barrier_complete(unsigned* bar, unsigned x, unsigned G, unsigned& nloc, unsigned& nx) {
    unsigned sum, cnt, mine, sp = 0u;
    for (;;) {
        sum = 0u; cnt = 0u; mine = 0u;
#pragma unroll
        for (unsigned j = 0; j < 16; ++j) { const unsigned c = xb_ld(&bar[XB_XCNT(j)]); sum += c; cnt += (c > 0u) ? 1u : 0u; mine = (j == x) ? c : mine; }
        if (sum == G) break;
        __builtin_amdgcn_s_sleep(1);
        if ((++sp & 255u) == 0u) { if (xb_ld(&bar[XB_TMO])) break; if (sp > XB_SPIN_CAP) { atomicAdd(&bar[XB_TMO], 1u); break; } }
    }
    nloc = mine > 0u ? mine : 1u; nx = cnt > 0u ? cnt : 1u;
}
__device__ __forceinline__ void xcd_barrier(unsigned* bar, volatile unsigned* st, bool leader, unsigned G) {
    asm volatile("s_waitcnt vmcnt(0)" ::: "memory");
    __syncthreads();
    if (leader) {
        const unsigned x = xb_xcc_id();
        __builtin_amdgcn_s_waitcnt(0);
        unsigned nloc = st[0], nx = st[1];
        if (nloc == 0u) { xcd_barrier_complete(bar, x, G, nloc, nx); st[0] = nloc; st[1] = nx; }
        const unsigned old = xb_add(&bar[XB_XSUB(x)], 1u);
        const unsigned gen = old / nloc;
        if (old + 1u == (gen + 1u) * nloc) {
            __builtin_amdgcn_fence(__ATOMIC_RELEASE, "agent");
            asm volatile("s_waitcnt vmcnt(0)" ::: "memory");
            const unsigned og = xb_add(&bar[XB_TOP], 1u);
            const unsigned tg = og / nx;
            if (og + 1u == (tg + 1u) * nx) xb_add(&bar[XB_TOPGEN], 1u);
            else XB_SPIN(xb_ld(&bar[XB_TOPGEN]) == tg, bar);
            __builtin_amdgcn_fence(__ATOMIC_ACQUIRE, "agent");
            xb_add(&bar[XB_XGEN(x)], 1u);
            asm volatile("s_waitcnt vmcnt(0)" ::: "memory");
        } else {
            XB_SPIN(xb_ld(&bar[XB_XGEN(x)]) == gen, bar);
            __builtin_amdgcn_fence(__ATOMIC_ACQUIRE, "agent");
            asm volatile("s_waitcnt vmcnt(0)" ::: "memory");
        }
    }
    __syncthreads();
}

constexpr int PH_PER_LAYER = 9, N_PHASES = DEPTH_ * PH_PER_LAYER + 1;

__device__ __forceinline__ void run_phase(const Params& p, int ph, int wid, unsigned char* shm) {
    unsigned char* ws = p.ws; float* X = p.out; int bid = blockIdx.x, nblk = gridDim.x;
    asm volatile("" : "+s"(ws), "+s"(X), "+s"(bid), "+s"(nblk), "+s"(wid));
    LAS unsigned char* lds = (LAS unsigned char*)shm;
    bf16_t* XB = (bf16_t*)(ws + WS_XB); bf16_t* BIG = (bf16_t*)(ws + WS_BIG);
    bf16_t* P1 = (bf16_t*)(ws + WS_P1); bf16_t* P2 = (bf16_t*)(ws + WS_P2);
    StaticOrder S;
    float* SSP = (float*)(ws + WS_SSP);
    bf16_t* XR = (bf16_t*)X;
    if (ph == N_PHASES - 1) { phase_final(bid, nblk, wid, P2, X, inp(p, I_GFINAL), SSP); return; }
    const int l = ph / PH_PER_LAYER, sp = ph - l * PH_PER_LAYER;
    switch (sp) {
    case 0: phase_prep(p, ws, bid, nblk, wid, l, shm); if (l == 0) phase_norm(bid, nblk, wid, inp(p, I_X), XR, SSP); break;
    case 1: case 7: { Gemm g{XR, (const bf16_t*)(ws + (sp == 1 ? W13A : W13B)), D_, D_, D_, T_, INW_, 0}; S.init(T_, INW_, nblk, bid);
        EpiSwiglu E{BIG, SSP, (const LAS float*)(lds + LDS_RS)}; gemm_phase(lds, g, S, E, wid); } break;
    case 2: case 8: { Gemm g{BIG, (const bf16_t*)(ws + (sp == 2 ? W2A : W2B)), FF_, FF_, FF_, T_, D_, 0}; S.init(T_, D_, nblk, bid);
        EpiResid E{XR, (sp == 8 && l == DEPTH_ - 1) ? P2 : XR, SSP, 0.5f, (LAS float*)(lds + LDS_RED)}; gemm_phase(lds, g, S, E, wid); } break;
    case 3: { Gemm g{XR, (const bf16_t*)(ws + WIN), D_, D_, D_, T_, INW_, 0}; S.init(T_, INW_, nblk, bid);
        EpiIn E{P1, P1 + (size_t)T_ * 512, P1 + (size_t)T_ * 1024, P1 + (size_t)T_ * 1536, BIG, SSP, (const LAS float*)(lds + LDS_RS)}; gemm_phase(lds, g, S, E, wid); } break;
    case 4: phase_mix(p, ws, bid, nblk, wid, l, shm); break;
    case 5: { S.init(T_, D_, nblk, bid);
        MergeOps g{XB, P2, (const bf16_t*)(ws + WF)}; EpiMergeSeg E{P1, BIG}; gemm_merge_phase(lds, g, S, E, wid); } break;
    case 6: { Gemm g{P1, (const bf16_t*)(ws + WO), D_, D_, D_, T_, D_, 0}; S.init(T_, D_, nblk, bid);
        EpiResid E{XR, XR, SSP, 1.0f, (LAS float*)(lds + LDS_RED)}; gemm_phase(lds, g, S, E, wid); } break;
    }
}

__global__ __launch_bounds__(512, 2) void mega(Params p) {
    extern __shared__ __attribute__((aligned(16))) unsigned char shm[];
    cg::grid_group grid = cg::this_grid();
    const int wid = __builtin_amdgcn_readfirstlane(threadIdx.x >> 6);
    volatile unsigned* st = (volatile unsigned*)(shm + STAGE_BYTES);
    if (threadIdx.x == 0) {
#pragma unroll
        for (int i = 0; i < 18; ++i) *(volatile LAS unsigned long long*)((LAS unsigned char*)shm + LDS_TBL + 8 * i) = (unsigned long long)p.in[i];
    }
    __syncthreads();
    if (p.coop) {
        if (wid == 0 && fresh_lane() == 0) { st[0] = 0u; st[1] = 0u; (void)xb_add(&((unsigned*)(p.ws + WS_BAR))[XB_XCNT(xb_xcc_id())], 1u); }
        __syncthreads();
    }
    for (int ph = p.ph_lo; ph < p.ph_hi; ++ph) {
        run_phase(p, ph, wid, shm);
        if (p.coop && ph + 1 < p.ph_hi) {
            if (ph == p.ph_lo) grid.sync();
            else { unsigned* bar = (unsigned*)(p.ws + WS_BAR); asm volatile("" : "+s"(bar)); const bool leader = (wid == 0) && (fresh_lane() == 0); xcd_barrier(bar, st, leader, gridDim.x); }
        }
    }
}

#ifndef MK_MULTI
#define MK_MULTI 0
#endif
extern "C" void kernel_launch(void* const* d_in, const int* in_sizes, int n_in, void* d_out, int out_size, void* d_ws, size_t ws_size, hipStream_t stream) {
    static int grid = 0;
    constexpr int LDS_BYTES = STAGE_BYTES + 256 + 4096 + 4096;
    if (grid == 0) {
        if (ws_size < WS_END) { fprintf(stderr, "kernel_launch: workspace too small: %zu < %zu\n", ws_size, (size_t)WS_END); grid = -1; return; }
        int dev = 0, cus = 0, per_cu = 0;
        hipGetDevice(&dev); hipDeviceGetAttribute(&cus, hipDeviceAttributeMultiprocessorCount, dev);
        if (hipFuncSetAttribute((const void*)mega, hipFuncAttributeMaxDynamicSharedMemorySize, LDS_BYTES) != hipSuccess) { fprintf(stderr, "kernel_launch: hipFuncSetAttribute failed\n"); }
        hipOccupancyMaxActiveBlocksPerMultiprocessor(&per_cu, (const void*)mega, 512, LDS_BYTES);
        (void)hipGetLastError();
        if (per_cu < 1) per_cu = 1;
        grid = cus;
        fprintf(stderr, "kernel_launch: cus %d per_cu %d grid %d ws %zu need %zu\n", cus, per_cu, grid, ws_size, (size_t)WS_END);
    }
    if (grid < 0) return;
    if (hipMemsetAsync((char*)d_ws + WS_BAR, 0, XCD_BAR_WORDS * 4, stream) != hipSuccess) { fprintf(stderr, "kernel_launch: memset failed\n"); return; }
    Params p{};
    for (int i = 0; i < 18; ++i) p.in[i] = (const float*)d_in[i];
    p.out = (float*)d_out; p.ws = (unsigned char*)d_ws;
#if MK_MULTI
    for (int ph = 0; ph < N_PHASES; ++ph) { p.ph_lo = ph; p.ph_hi = ph + 1; p.coop = 0; hipLaunchKernelGGL(mega, dim3(grid), dim3(512), LDS_BYTES, stream, p); }
#else
    p.ph_lo = 0; p.ph_hi = N_PHASES; p.coop = 1;
    void* args[] = {&p};
    hipError_t e = hipLaunchCooperativeKernel((const void*)mega, dim3(grid), dim3(512), args, LDS_BYTES, stream);
    if (e != hipSuccess) fprintf(stderr, "cooperative launch failed: %s (grid %d)\n", hipGetErrorString(e), grid);
#endif
}
```
